# Optimizing an MI355X kernel written in HIP

```python
import math
import jax
import jax.numpy as jnp
from jax import lax
import numpy as np

D_MODEL = 1024
BATCH = 8
SEQ = 4096
DEPTH = 4

N_EVEN = (DEPTH + 1) // 2
N_ODD = DEPTH // 2
RMS_EPS = 1e-6

A_HEADS = 8
A_KV_HEADS = 2
A_HEAD_DIM = 64
A_WINDOW = 128
B_HEADS = 4
B_KEY_DIM = 64
B_VAL_DIM = 128
B_GATE_RANK = 16
B_GATE_TAU = 16.0
B_CHUNK = 64
C_HEADS = 8
C_HEAD_DIM = 128
C_BLOCK = 256
C_TOPK = 3
C_ROW_BLOCK = 128
REL_BUCKETS = 32
REL_MAX_DIST = 128
REL_HEADS = 8
MOE_GROUPS = 4
MOE_EXPERTS_PER_GROUP = 8
MOE_EXPERTS = MOE_GROUPS * MOE_EXPERTS_PER_GROUP
MOE_TOPK = 2
MOE_HIDDEN = 512
MOE_ROW_BLOCK = 128

EVEN_SPLITS = (A_HEADS * A_HEAD_DIM, A_KV_HEADS * A_HEAD_DIM, A_KV_HEADS * A_HEAD_DIM,
               B_HEADS * B_KEY_DIM, B_HEADS * B_KEY_DIM, B_HEADS * B_VAL_DIM,
               B_HEADS * B_VAL_DIM, B_GATE_RANK)
EVEN_IN = sum(EVEN_SPLITS)
EVEN_MIX = A_HEADS * A_HEAD_DIM + B_HEADS * B_VAL_DIM
ODD_MIX = C_HEADS * C_HEAD_DIM

kernel_name = 'hybrid_swa_gla_moba_hmoe_block'


def _rms(x, w):
    xf = x.astype(jnp.float32)
    y = xf * lax.rsqrt(jnp.mean(xf * xf, axis=-1, keepdims=True) + RMS_EPS)
    return (y * w.astype(jnp.float32)).astype(x.dtype)


def _rel_bucket(dist):
    exact = REL_BUCKETS // 2
    d = jnp.maximum(dist, 0)
    logd = jnp.log(jnp.maximum(d, 1).astype(jnp.float32) / exact) / math.log(REL_MAX_DIST / exact)
    far = jnp.minimum(exact + (logd * (REL_BUCKETS - exact)).astype(jnp.int32), REL_BUCKETS - 1)
    return jnp.where(d < exact, d, far)


def _group_rows(ids, n_groups, rows):
    n = ids.shape[0]
    n_rows = ((n + rows - 1) // rows) * rows + n_groups * rows
    counts = jnp.zeros((n_groups + 1,), jnp.int32).at[ids].add(1)[:n_groups]
    padded = ((counts + rows - 1) // rows) * rows
    start = jnp.cumsum(counts) - counts
    pend = jnp.cumsum(padded)
    pstart = pend - padded
    order = jnp.argsort(ids)
    sid = ids[order]
    gid = jnp.minimum(sid, n_groups - 1)
    dest = jnp.where(sid < n_groups, pstart[gid] + jnp.arange(n) - start[gid], n_rows)
    src = jnp.full((n_rows,), n, jnp.int32).at[dest].set(order.astype(jnp.int32), mode='drop')
    blk_group = jnp.searchsorted(pend, jnp.arange(n_rows // rows) * rows, side='right')
    return src, jnp.minimum(blk_group, n_groups - 1)


def _swa_sink_attention(q, k, v, sinks, rel_bias):
    B, S, _, hd = q.shape
    W = A_WINDOW
    nb = S // W
    G = A_HEADS // A_KV_HEADS
    f32 = jnp.float32
    qb = q.reshape(B, nb, W, A_KV_HEADS, G, hd)

    def band(t):
        tb = t.reshape(B, nb, W, A_KV_HEADS, hd)
        prev = jnp.pad(tb, ((0, 0), (1, 0), (0, 0), (0, 0), (0, 0)))[:, :-1]
        return jnp.concatenate([prev, tb], axis=2)

    kband, vband = band(k), band(v)
    lg = jnp.einsum('bnqkgd,bnskd->bkgnqs', qb, kband, preferred_element_type=f32) * hd ** -0.5
    dist = jnp.arange(W)[:, None] + W - jnp.arange(2 * W)[None, :]
    mask = ((dist >= 0) & (dist < W)
            & ((jnp.arange(nb)[:, None, None] > 0) | (jnp.arange(2 * W) >= W)[None, None, :]))
    bias = rel_bias[_rel_bucket(dist)].transpose(2, 0, 1).reshape(A_KV_HEADS, G, 1, W, 2 * W)
    lg = jnp.where(mask, lg + bias, -jnp.inf)
    sink = sinks.astype(f32).reshape(A_KV_HEADS, G, 1, 1, 1)
    m = jnp.maximum(lg.max(-1, keepdims=True), sink)
    p = jnp.exp(lg - m)
    probs = p / (p.sum(-1, keepdims=True) + jnp.exp(sink - m))
    o = jnp.einsum('bkgnqs,bnskd->bnqkgd', probs.astype(v.dtype), vband, preferred_element_type=f32)
    return o.reshape(B, S, A_HEADS * hd)


def _gla(q, k, v, log_a):
    B, S, H, dk = q.shape
    dv = v.shape[-1]
    C = B_CHUNK
    n = S // C

    def chunks(t):
        return t.reshape(B, n, C, H, t.shape[-1]).transpose(0, 3, 1, 2, 4)

    q, k, v, g = chunks(q * dk ** -0.5), chunks(k), chunks(v), chunks(log_a)
    b = jnp.cumsum(g, axis=3)
    b_last = b[:, :, :, -1:]
    q_dec = q * jnp.exp(b)
    att = jnp.einsum('bhnid,bhnjd->bhnij', q_dec, k * jnp.exp(-b))
    att = jnp.where(jnp.tril(jnp.ones((C, C), bool)), att, 0.0)
    o_intra = jnp.einsum('bhnij,bhnjv->bhniv', att, v)
    upd = jnp.einsum('bhnjd,bhnjv->bhndv', k * jnp.exp(b_last - b), v)
    decay = jnp.exp(b_last[:, :, :, 0])

    def step(state, inp):
        dec, u = inp
        return state * dec[..., None] + u, state

    _, s_in = lax.scan(step, jnp.zeros((B, H, dk, dv), q.dtype),
                       (decay.transpose(2, 0, 1, 3), upd.transpose(2, 0, 1, 3, 4)))
    o_inter = jnp.einsum('bhnid,bhndv->bhniv', q_dec, s_in.transpose(1, 2, 0, 3, 4))
    return (o_intra + o_inter).transpose(0, 2, 3, 1, 4).reshape(B, S, H, dv)


def _moba(q, k, v, rel_bias):
    B, S, H, hd = q.shape
    L = C_BLOCK
    nb = -(-S // L)
    Sp = nb * L
    k_sel = min(C_TOPK, nb)
    scale = hd ** -0.5
    f32 = jnp.float32
    q, k, v = [jnp.pad(t, ((0, 0), (0, Sp - S), (0, 0), (0, 0))).transpose(0, 2, 1, 3) for t in (q, k, v)]
    qb = q.reshape(B, H, nb, L, hd)
    kb = k.reshape(B, H, nb, L, hd)
    vb = v.reshape(B, H, nb, L, hd)
    li = jnp.arange(L)
    d_own = li[:, None] - li[None, :]
    bias_own = rel_bias[_rel_bucket(d_own)].transpose(2, 0, 1)[None, :, None]
    lg = jnp.einsum('bhnqd,bhnsd->bhnqs', qb, kb, preferred_element_type=f32) * scale + bias_own
    lg = jnp.where(d_own >= 0, lg, -jnp.inf)
    lse_own = jax.nn.logsumexp(lg, axis=-1)
    o_own = jnp.einsum('bhnqs,bhnsd->bhnqd', jnp.exp(lg - lse_own[..., None]).astype(v.dtype), vb,
                       preferred_element_type=f32)
    pos = jnp.arange(Sp)
    qblk = pos // L
    score = jnp.einsum('bhtd,bhjd->bhtj', q.astype(f32), kb.astype(f32).mean(axis=3))
    score = jnp.where(jnp.arange(nb)[None, :] < qblk[:, None], score, -jnp.inf)
    _, sel = lax.top_k(score, k_sel)
    valid = (jnp.arange(k_sel)[None, :] < jnp.minimum(qblk, k_sel)[:, None]) & (pos < S)[:, None]
    n_groups = B * H * nb
    grp = jnp.arange(B * H).reshape(B, H, 1, 1) * nb + sel
    grp = jnp.where(valid, grp, n_groups).reshape(-1)
    src, blk_grp = _group_rows(grp, n_groups, C_ROW_BLOCK)
    n_pairs = grp.shape[0]
    row_ok = src < n_pairs
    row_tok = jnp.minimum(src, n_pairs - 1) // k_sel
    n_tok = B * H * Sp
    q_rows = q.reshape(n_tok, hd)
    k_grp = kb.reshape(n_groups, L, hd)
    v_grp = vb.reshape(n_groups, L, hd)

    def attend_block(args):
        tok, g = args
        qr = q_rows[tok]
        dist = (tok % Sp)[:, None] - ((g % nb) * L + li)[None, :]
        bias = rel_bias[_rel_bucket(dist), (g // nb) % H]
        lg_r = jnp.einsum('rd,sd->rs', qr, k_grp[g], preferred_element_type=f32) * scale + bias
        lse_r = jax.nn.logsumexp(lg_r, axis=-1)
        o_r = jnp.einsum('rs,sd->rd', jnp.exp(lg_r - lse_r[:, None]).astype(v.dtype), v_grp[g],
                         preferred_element_type=f32)
        return o_r, lse_r

    o_sel, lse_sel = lax.map(attend_block, (row_tok.reshape(-1, C_ROW_BLOCK), blk_grp))
    o_sel = o_sel.reshape(-1, hd)
    lse_sel = lse_sel.reshape(-1)
    seg = jnp.where(row_ok, row_tok, n_tok)
    lse_own = lse_own.reshape(n_tok)
    m_sel = jax.ops.segment_max(jnp.where(row_ok, lse_sel, -jnp.inf), seg, num_segments=n_tok + 1)[:n_tok]
    m = jnp.maximum(lse_own, m_sel)
    w_sel = jnp.where(row_ok, jnp.exp(lse_sel - m[jnp.minimum(seg, n_tok - 1)]), 0.0)
    w_own = jnp.exp(lse_own - m)
    num = (w_own[:, None] * o_own.reshape(n_tok, hd)
           + jax.ops.segment_sum(w_sel[:, None] * o_sel, seg, num_segments=n_tok + 1)[:n_tok])
    den = w_own + jax.ops.segment_sum(w_sel, seg, num_segments=n_tok + 1)[:n_tok]
    o = (num / den[:, None]).reshape(B, H, Sp, hd)[:, :, :S]
    return o.transpose(0, 2, 1, 3).reshape(B, S, H * hd).astype(q.dtype)


def _even_mixer(h, w_in, w_out, q_norm, k_norm, sinks, gate_up, gate_bias, out_norm, rel_bias):
    B, S, _ = h.shape
    f32 = jnp.float32
    qa, ka, va, qb, kb, vb, rb, ab = jnp.split(h @ w_in, np.cumsum(EVEN_SPLITS)[:-1].tolist(), axis=-1)
    qa = _rms(qa.reshape(B, S, A_HEADS, A_HEAD_DIM), q_norm)
    ka = _rms(ka.reshape(B, S, A_KV_HEADS, A_HEAD_DIM), k_norm)
    va = va.reshape(B, S, A_KV_HEADS, A_HEAD_DIM)
    oa = _swa_sink_attention(qa, ka, va, sinks, rel_bias).astype(h.dtype)
    log_a = jax.nn.log_sigmoid((ab @ gate_up + gate_bias).astype(f32)) / B_GATE_TAU
    ob = _gla(qb.reshape(B, S, B_HEADS, B_KEY_DIM).astype(f32),
              kb.reshape(B, S, B_HEADS, B_KEY_DIM).astype(f32),
              vb.reshape(B, S, B_HEADS, B_VAL_DIM).astype(f32),
              log_a.reshape(B, S, B_HEADS, B_KEY_DIM))
    ob = _rms(ob, out_norm).astype(h.dtype) * jax.nn.silu(rb).reshape(B, S, B_HEADS, B_VAL_DIM)
    return jnp.concatenate([oa, ob.reshape(B, S, B_HEADS * B_VAL_DIM)], axis=-1) @ w_out


def _odd_mixer(h, w_in, w_out, q_norm, k_norm, rel_bias):
    B, S, _ = h.shape
    q, k, v = jnp.split(h @ w_in, 3, axis=-1)
    q = _rms(q.reshape(B, S, C_HEADS, C_HEAD_DIM), q_norm)
    k = _rms(k.reshape(B, S, C_HEADS, C_HEAD_DIM), k_norm)
    v = v.reshape(B, S, C_HEADS, C_HEAD_DIM)
    return _moba(q, k, v, rel_bias) @ w_out


def _hier_moe(h, w_group, b_group, w_expert, b_expert, w1, w3, w2):
    B, S, D = h.shape
    N = B * S
    f32 = jnp.float32
    xt = h.reshape(N, D)
    g_logits = (xt @ w_group).astype(f32) + b_group.astype(f32)
    g_sel = jnp.argmax(g_logits, axis=-1)
    p_g = jnp.take_along_axis(jax.nn.softmax(g_logits, axis=-1), g_sel[:, None], axis=-1)
    e_logits = ((xt @ w_expert).astype(f32) + b_expert.astype(f32)).reshape(N, MOE_GROUPS, MOE_EXPERTS_PER_GROUP)
    e_in = jnp.take_along_axis(e_logits, g_sel[:, None, None], axis=1)[:, 0]
    top_v, top_i = lax.top_k(e_in, MOE_TOPK)
    gate = (p_g * jax.nn.softmax(top_v, axis=-1)).reshape(-1)
    ids = (g_sel[:, None] * MOE_EXPERTS_PER_GROUP + top_i).reshape(-1)
    src, blk_e = _group_rows(ids, MOE_EXPERTS, MOE_ROW_BLOCK)
    n_pairs = ids.shape[0]
    row_ok = src < n_pairs
    pair = jnp.minimum(src, n_pairs - 1)
    row_tok = pair // MOE_TOPK

    def expert_block(args):
        tok, e = args
        xr = xt[tok]
        return (jax.nn.silu(xr @ w1[e]) * (xr @ w3[e])) @ w2[e]

    y = lax.map(expert_block, (row_tok.reshape(-1, MOE_ROW_BLOCK), blk_e)).reshape(-1, D)
    w_row = jnp.where(row_ok, gate[pair], 0.0).astype(y.dtype)
    seg = jnp.where(row_ok, row_tok, N)
    out = jax.ops.segment_sum(y * w_row[:, None], seg, num_segments=N + 1)[:N]
    return out.reshape(B, S, D)


def setup_inputs(seed: int = 0) -> dict:
    key = jax.random.key(seed)
    ks = iter(jax.random.split(key, 32))
    D = D_MODEL

    def nrm(shape, s):
        return jax.random.normal(next(ks), shape, jnp.float32) * s

    return {
        'x': nrm((BATCH, SEQ, D), 1.0),
        'c': nrm((BATCH, D), 1.0),
        'rel_bias': nrm((REL_BUCKETS, REL_HEADS), 0.5),
        'ada_w': nrm((DEPTH, D, 6 * D), 0.5 * D ** -0.5),
        'ada_b': nrm((DEPTH, 6 * D), 0.02),
        'norm1_w': 1.0 + nrm((DEPTH, D), 0.05),
        'norm2_w': 1.0 + nrm((DEPTH, D), 0.05),
        'even_w_in': nrm((N_EVEN, D, EVEN_IN), D ** -0.5),
        'even_w_out': nrm((N_EVEN, EVEN_MIX, D), EVEN_MIX ** -0.5),
        'a_q_norm': 1.0 + nrm((N_EVEN, A_HEAD_DIM), 0.05),
        'a_k_norm': 1.0 + nrm((N_EVEN, A_HEAD_DIM), 0.05),
        'a_sinks': nrm((N_EVEN, A_HEADS), 0.5),
        'b_gate_up': nrm((N_EVEN, B_GATE_RANK, B_HEADS * B_KEY_DIM), B_GATE_RANK ** -0.5),
        'b_gate_bias': nrm((N_EVEN, B_HEADS * B_KEY_DIM), 0.1),
        'b_out_norm': 1.0 + nrm((N_EVEN, B_VAL_DIM), 0.05),
        'odd_w_in': nrm((N_ODD, D, 3 * ODD_MIX), D ** -0.5),
        'odd_w_out': nrm((N_ODD, ODD_MIX, D), ODD_MIX ** -0.5),
        'c_q_norm': 1.0 + nrm((N_ODD, C_HEAD_DIM), 0.05),
        'c_k_norm': 1.0 + nrm((N_ODD, C_HEAD_DIM), 0.05),
        'moe_w_group': nrm((DEPTH, D, MOE_GROUPS), D ** -0.5),
        'moe_b_group': nrm((DEPTH, MOE_GROUPS), 0.01),
        'moe_w_expert': nrm((DEPTH, D, MOE_EXPERTS), D ** -0.5),
        'moe_b_expert': nrm((DEPTH, MOE_EXPERTS), 0.01),
        'moe_w1': nrm((DEPTH, MOE_EXPERTS, D, MOE_HIDDEN), D ** -0.5),
        'moe_w3': nrm((DEPTH, MOE_EXPERTS, D, MOE_HIDDEN), D ** -0.5),
        'moe_w2': nrm((DEPTH, MOE_EXPERTS, MOE_HIDDEN, D), MOE_HIDDEN ** -0.5),
    }


def reference(x, c, rel_bias, ada_w, ada_b, norm1_w, norm2_w, even_w_in, even_w_out, a_q_norm,
              a_k_norm, a_sinks, b_gate_up, b_gate_bias, b_out_norm, odd_w_in, odd_w_out, c_q_norm,
              c_k_norm, moe_w_group, moe_b_group, moe_w_expert, moe_b_expert, moe_w1, moe_w3, moe_w2):
    cond = jax.nn.silu(c)
    for layer in range(DEPTH):
        mod = (cond @ ada_w[layer] + ada_b[layer])[:, None, :]
        shift1, scale1, gate1, shift2, scale2, gate2 = jnp.split(mod, 6, axis=-1)
        h = _rms(x, norm1_w[layer]) * (1 + scale1) + shift1
        j = layer // 2
        if layer % 2 == 0:
            y = _even_mixer(h, even_w_in[j], even_w_out[j], a_q_norm[j], a_k_norm[j], a_sinks[j],
                            b_gate_up[j], b_gate_bias[j], b_out_norm[j], rel_bias)
        else:
            y = _odd_mixer(h, odd_w_in[j], odd_w_out[j], c_q_norm[j], c_k_norm[j], rel_bias)
        x = x + gate1 * y
        h = _rms(x, norm2_w[layer]) * (1 + scale2) + shift2
        x = x + gate2 * _hier_moe(h, moe_w_group[layer], moe_b_group[layer], moe_w_expert[layer],
                                  moe_b_expert[layer], moe_w1[layer], moe_w3[layer], moe_w2[layer])
    return x
```

```cpp
#include <hip/hip_runtime.h>
#include <cstdio>
#include <cstdint>

#define DEV __device__ __forceinline__
typedef unsigned short bf16;
typedef float f32x4 __attribute__((ext_vector_type(4)));
typedef float f32x2 __attribute__((ext_vector_type(2)));
typedef unsigned u32x2 __attribute__((ext_vector_type(2)));
typedef unsigned u32x4 __attribute__((ext_vector_type(4)));

constexpr int DM = 1024, NBATCH = 8, SEQ = 4096, NTOK = NBATCH * SEQ, DEPTH = 4;
constexpr int EVEN_IN = 2320, EVN = 2304, ODN = 3072;
constexpr int NEXP = 32, MOEH = 512, NPAIR = 2 * NTOK, MOE_ROWS = 73728;
constexpr float RMS_EPS = 1e-6f;
enum { I_X = 0, I_C, I_RELB, I_ADAW, I_ADAB, I_N1W, I_N2W, I_EWIN, I_EWOUT, I_AQN, I_AKN, I_ASINK, I_BGU, I_BGB, I_BON, I_OWIN, I_OWOUT, I_CQN, I_CKN,
       I_MWG, I_MBG, I_MWE, I_MBE, I_MW1, I_MW3, I_MW2, N_IN };
struct Params { const float* in[N_IN]; float* out; unsigned char* ws; int ph_lo, ph_hi; };

constexpr size_t al256(size_t x) { return (x + 255) & ~(size_t)255; }
constexpr size_t WS_CTL = 0, CTL_BYTES = 1u << 20;
constexpr size_t WS_MOD = WS_CTL + CTL_BYTES;
constexpr size_t WS_BT = WS_MOD + al256((size_t)DEPTH * NBATCH * 6 * DM * 4);
constexpr size_t WS_KMEAN = WS_BT + al256(8 * 128 * 4);
constexpr size_t WS_AB = WS_KMEAN + al256((size_t)NBATCH * 16 * 8 * 128 * 4);
constexpr size_t WS_PAIRE = WS_AB + al256((size_t)NTOK * 16 * 4);
constexpr size_t WS_PAIRS = WS_PAIRE + al256((size_t)NPAIR * 4);
constexpr size_t WS_PAIRG = WS_PAIRS + al256((size_t)NPAIR * 4);
constexpr size_t WS_LIST = WS_PAIRG + al256((size_t)NPAIR * 4);
constexpr size_t WS_WEI = WS_LIST + al256((size_t)NEXP * NTOK * 4);
constexpr size_t WS_WEO = WS_WEI + al256((size_t)2 * EVN * DM * 2);
constexpr size_t WS_WOI = WS_WEO + al256((size_t)2 * DM * DM * 2);
constexpr size_t WS_WOO = WS_WOI + al256((size_t)2 * ODN * DM * 2);
constexpr size_t WS_WUP = WS_WOO + al256((size_t)2 * DM * DM * 2);
constexpr size_t WS_WDN = WS_WUP + al256((size_t)DEPTH * NEXP * 1024 * DM * 2);
constexpr size_t WS_H = WS_WDN + al256((size_t)DEPTH * NEXP * DM * MOEH * 2);
constexpr size_t WS_MIX = WS_H + al256((size_t)NTOK * DM * 2);
constexpr size_t WS_UPD = WS_MIX + al256((size_t)NTOK * DM * 2);
constexpr size_t WS_SIN = WS_UPD + al256((size_t)2048 * 64 * 128 * 4);
constexpr size_t WS_DEC = WS_SIN + al256((size_t)2048 * 64 * 128 * 4);
constexpr size_t WS_BIG = WS_DEC + al256((size_t)2048 * 64 * 4);
constexpr size_t WS_ACT = WS_BIG, WS_YP = WS_BIG + al256((size_t)MOE_ROWS * MOEH * 2);
constexpr size_t BIG_BYTES = al256((size_t)MOE_ROWS * MOEH * 2) + al256((size_t)MOE_ROWS * DM * 2);
static_assert(BIG_BYTES >= (size_t)NTOK * ODN * 2, "QKV fits the union");
constexpr size_t WS_END = WS_BIG + BIG_BYTES;
constexpr int CW_CNT = 64;
constexpr int CW_BAR = 4096;

__device__ const unsigned char REL_BUCKET[128] = {0,1,2,3,4,5,6,7,8,9,10,11,12,13,14,15,16,16,16,17,17,18,18,18,19,19,19,20,20,20,20,21,21,21,21,22,22,22,22,22,23,23,23,23,23,23,24,24,24,24,24,24,25,25,25,25,25,25,25,26,26,26,26,26,26,26,26,27,27,27,27,27,27,27,27,27,27,28,28,28,28,28,28,28,28,28,28,29,29,29,29,29,29,29,29,29,29,29,29,30,30,30,30,30,30,30,30,30,30,30,30,30,30,31,31,31,31,31,31,31,31,31,31,31,31,31,31,31};

DEV float bf2f(bf16 v) { return __uint_as_float((unsigned)v << 16); }
DEV float bflo(unsigned u) { return __uint_as_float(u << 16); }
DEV float bfhi(unsigned u) { return __uint_as_float(u & 0xffff0000u); }
DEV unsigned f2bf(float f) { unsigned u = __float_as_uint(f); return (u + 0x7fffu + ((u >> 16) & 1u)) >> 16; }
DEV unsigned pk2(float lo, float hi) { return f2bf(lo) | (f2bf(hi) << 16); }
DEV float wave_sum(float v) {
#pragma unroll
    for (int o = 1; o < 64; o <<= 1) v += __shfl_xor(v, o);
    return v;
}
DEV float wave_max(float v) {
#pragma unroll
    for (int o = 1; o < 64; o <<= 1) v = fmaxf(v, __shfl_xor(v, o));
    return v;
}
DEV float silu_f(float x) { return x / (1.f + __expf(-x)); }
DEV float log_sigmoid_f(float x) { return fminf(x, 0.f) - log1pf(__expf(-fabsf(x))); }
DEV void moe_rowbase(const unsigned* cnt, int* rb  ) { int a = 0; for (int e = 0; e < NEXP; ++e) { rb[e] = a; a += ((int)cnt[e] + 255) & ~255; } rb[NEXP] = a; }

DEV void phase_prologue(const Params& P, unsigned char* lds, int vb, int nvb) {
    const int tid = threadIdx.x, lane = tid & 63, wave = tid >> 6;
    float* cond = (float*)lds;
    float* red = (float*)(lds + 32768);
    const float* c = P.in[I_C];
    for (int i = tid; i < NBATCH * DM; i += 512) cond[i] = silu_f(c[i]);
    __syncthreads();
    float* MOD = (float*)(P.ws + WS_MOD);
    const float* adaw = P.in[I_ADAW]; const float* adab = P.in[I_ADAB];
    for (int u = vb; u < DEPTH * 96; u += nvb) {
        const int l = u / 96, col = (u % 96) * 64 + lane;
        float acc[8];
#pragma unroll
        for (int b = 0; b < 8; ++b) acc[b] = 0.f;
        const float* wp = adaw + ((size_t)l * DM + wave * 128) * (6 * DM) + col;
#pragma unroll 4
        for (int k = 0; k < 128; ++k) {
            const float w = wp[(size_t)k * (6 * DM)];
#pragma unroll
            for (int b = 0; b < 8; ++b) acc[b] += cond[b * DM + wave * 128 + k] * w;
        }
#pragma unroll
        for (int b = 0; b < 8; ++b) red[(wave * 8 + b) * 64 + lane] = acc[b];
        __syncthreads();
        {
            float s = 0.f;
#pragma unroll
            for (int w = 0; w < 8; ++w) s += red[(w * 8 + wave) * 64 + lane];
            MOD[((size_t)l * NBATCH + wave) * (6 * DM) + col] = s + adab[(size_t)l * 6 * DM + col];
        }
        __syncthreads();
    }
    if (vb == 0) {
        float* BT = (float*)(P.ws + WS_BT); const float* rb = P.in[I_RELB];
        for (int i = tid; i < 8 * 128; i += 512) { const int h = i >> 7, d = i & 127; BT[i] = rb[REL_BUCKET[d] * 8 + h]; }
    }
}

DEV void phase_norm(const Params& P, unsigned char* lds, int vb, int nvb, int mode, int layer, const float* xsrc, float* xdst, int clayer  ) {
    const int tid = threadIdx.x, lane = tid & 63, wave = tid >> 6;
    float* tab = (float*)lds;
    int* lcnt = (int*)(lds + 147456);
    int* lbase = lcnt + 32;
    int* rowb = lbase + 32;
    int* plist = rowb + 64;
    int* pn = plist + 512;
    const unsigned* ctl = (const unsigned*)(P.ws + WS_CTL);
    float* MOD = (float*)(P.ws + WS_MOD);
    if (mode == 1) { const float* w = P.in[I_EWIN] + (size_t)(layer >> 1) * DM * EVEN_IN;
        for (int i = tid; i < DM * 16; i += 512) { const int k = i >> 4, j = i & 15; tab[j * DM + k] = w[(size_t)k * EVEN_IN + EVN + j]; } }
    if (mode == 3) { const float* wg = P.in[I_MWG] + (size_t)layer * DM * 4; const float* we = P.in[I_MWE] + (size_t)layer * DM * 32;
        for (int i = tid; i < DM * 4; i += 512) { const int k = i >> 2, j = i & 3; tab[j * DM + k] = wg[i]; }
        for (int i = tid; i < DM * 32; i += 512) { const int k = i >> 5, j = i & 31; tab[(4 + j) * DM + k] = we[i]; }
        if (tid < 32) lcnt[tid] = 0; if (tid == 0) pn[0] = 0; }
    if (clayer >= 0 && tid == 0) moe_rowbase(ctl + CW_CNT + clayer * 32, rowb);
    __syncthreads();
    const int* PE = (const int*)(P.ws + WS_PAIRE); const int* PS = (const int*)(P.ws + WS_PAIRS); const float* PG = (const float*)(P.ws + WS_PAIRG);
    const bf16* YP = (const bf16*)(P.ws + WS_YP);
    bf16* H = (bf16*)(P.ws + WS_H);
    for (int r = vb * 8 + wave; r < NTOK; r += nvb * 8) {
        const int b = r >> 12;
        f32x4 v[4];
#pragma unroll
        for (int j = 0; j < 4; ++j) v[j] = *(const f32x4*)(xsrc + (size_t)r * DM + j * 256 + lane * 4);
        if (clayer >= 0) {
            const int e0 = PE[2 * r], e1 = PE[2 * r + 1]; const float g0 = PG[2 * r], g1 = PG[2 * r + 1];
            const size_t p0 = (size_t)(rowb[e0] + PS[2 * r]), p1 = (size_t)(rowb[e1] + PS[2 * r + 1]);
            const float* gate2 = MOD + ((size_t)clayer * NBATCH + b) * (6 * DM) + 5 * DM;
#pragma unroll
            for (int j = 0; j < 4; ++j) {
                const u32x2 y0 = *(const u32x2*)(YP + p0 * DM + j * 256 + lane * 4), y1 = *(const u32x2*)(YP + p1 * DM + j * 256 + lane * 4);
                const f32x4 g = *(const f32x4*)(gate2 + j * 256 + lane * 4);
                f32x4 m;
                m.x = g0 * bflo(y0.x) + g1 * bflo(y1.x); m.y = g0 * bfhi(y0.x) + g1 * bfhi(y1.x);
                m.z = g0 * bflo(y0.y) + g1 * bflo(y1.y); m.w = g0 * bfhi(y0.y) + g1 * bfhi(y1.y);
                v[j] = v[j] + g * m;
                if (xdst) *(f32x4*)(xdst + (size_t)r * DM + j * 256 + lane * 4) = v[j];
            }
        }
        if (mode == 0) continue;
        float ss = 0.f;
#pragma unroll
        for (int j = 0; j < 4; ++j) ss += (v[j].x * v[j].x + v[j].y * v[j].y) + (v[j].z * v[j].z + v[j].w * v[j].w);
        const float rstd = rsqrtf(wave_sum(ss) * (1.f / DM) + RMS_EPS);
        const float* nw = P.in[mode == 3 ? I_N2W : I_N1W] + (size_t)layer * DM;
        const float* modr = MOD + ((size_t)layer * NBATCH + b) * (6 * DM) + (mode == 3 ? 3 * DM : 0);
#pragma unroll
        for (int j = 0; j < 4; ++j) {
            const int c0 = j * 256 + lane * 4;
            const f32x4 w = *(const f32x4*)(nw + c0), sh = *(const f32x4*)(modr + c0), sc = *(const f32x4*)(modr + DM + c0);
            v[j] = (v[j] * rstd * w) * (sc + 1.f) + sh;
            u32x2 o; o.x = pk2(v[j].x, v[j].y); o.y = pk2(v[j].z, v[j].w);
            *(u32x2*)(H + (size_t)r * DM + c0) = o;
        }
        if (mode == 1) {
            float ab[16];
#pragma unroll
            for (int q = 0; q < 16; ++q) { float a = 0.f;
#pragma unroll
                for (int j = 0; j < 4; ++j) { const f32x4 t = *(const f32x4*)(tab + q * DM + j * 256 + lane * 4); a += (v[j].x * t.x + v[j].y * t.y) + (v[j].z * t.z + v[j].w * t.w); }
                ab[q] = wave_sum(a); }
            float mine = 0.f;
#pragma unroll
            for (int q = 0; q < 16; ++q) mine = (lane == q) ? ab[q] : mine;
            if (lane < 16) ((float*)(P.ws + WS_AB))[(size_t)r * 16 + lane] = mine;
        }
        if (mode == 3) {
            float lg[36];
#pragma unroll
            for (int q = 0; q < 36; ++q) { float a = 0.f;
#pragma unroll
                for (int j = 0; j < 4; ++j) { const f32x4 t = *(const f32x4*)(tab + q * DM + j * 256 + lane * 4); a += (v[j].x * t.x + v[j].y * t.y) + (v[j].z * t.z + v[j].w * t.w); }
                lg[q] = wave_sum(a); }
            const float* bg = P.in[I_MBG] + layer * 4; const float* be = P.in[I_MBE] + layer * 32;
            float gl[4];
#pragma unroll
            for (int i = 0; i < 4; ++i) gl[i] = lg[i] + bg[i];
            int g = 0; float gm = gl[0];
#pragma unroll
            for (int i = 1; i < 4; ++i) if (gl[i] > gm) { gm = gl[i]; g = i; }
            float den = 0.f;
#pragma unroll
            for (int i = 0; i < 4; ++i) den += __expf(gl[i] - gm);
            const float pg = 1.f / den;
            float el[8];
#pragma unroll
            for (int i = 0; i < 8; ++i) { const float a0 = lg[4 + i] + be[i], a1 = lg[12 + i] + be[8 + i], a2 = lg[20 + i] + be[16 + i], a3 = lg[28 + i] + be[24 + i];
                el[i] = g == 0 ? a0 : (g == 1 ? a1 : (g == 2 ? a2 : a3)); }
            int i1 = 0; float v1 = el[0];
#pragma unroll
            for (int i = 1; i < 8; ++i) if (el[i] > v1) { v1 = el[i]; i1 = i; }
            int i2 = -1; float v2 = -INFINITY;
#pragma unroll
            for (int i = 0; i < 8; ++i) if (i != i1 && el[i] > v2) { v2 = el[i]; i2 = i; }
            const float t2 = __expf(v2 - v1), w1 = 1.f / (1.f + t2), w2 = t2 * w1;
            if (lane == 0) {
                const int ea = g * 8 + i1, eb = g * 8 + i2;
                int* PEw = (int*)(P.ws + WS_PAIRE); float* PGw = (float*)(P.ws + WS_PAIRG);
                PEw[2 * r] = ea; PEw[2 * r + 1] = eb; PGw[2 * r] = pg * w1; PGw[2 * r + 1] = pg * w2;
                const int sa = atomicAdd(&lcnt[ea], 1), sb = atomicAdd(&lcnt[eb], 1);
                const int ix = atomicAdd(&pn[0], 2);
                plist[2 * ix] = 2 * r; plist[2 * ix + 1] = (ea << 16) | sa; plist[2 * ix + 2] = 2 * r + 1; plist[2 * ix + 3] = (eb << 16) | sb;
            }
        }
    }
    if (mode == 3) {
        __syncthreads();
        unsigned* cnt = (unsigned*)(P.ws + WS_CTL) + CW_CNT + layer * 32;
        if (tid < 32) lbase[tid] = (int)__hip_atomic_fetch_add(cnt + tid, (unsigned)lcnt[tid], __ATOMIC_RELAXED, __HIP_MEMORY_SCOPE_AGENT);
        __syncthreads();
        int* LIST = (int*)(P.ws + WS_LIST); int* PSw = (int*)(P.ws + WS_PAIRS);
        const int n = pn[0];
        for (int i = tid; i < n; i += 512) { const int pair = plist[2 * i], es = plist[2 * i + 1], e = es >> 16, slot = lbase[e] + (es & 0xffff);
            LIST[(size_t)e * NTOK + slot] = pair; PSw[pair] = slot; }
    }
}

DEV void phase_kprep(const Params& P, unsigned char* lds, int vb, int nvb, int layer) {
    const int tid = threadIdx.x, lane = tid & 63, wave = tid >> 6;
    float* red = (float*)lds;
    bf16* QKV = (bf16*)(P.ws + WS_BIG); float* KM = (float*)(P.ws + WS_KMEAN);
    const float* kn = P.in[I_CKN] + (layer >> 1) * 128;
    const float w0 = kn[2 * lane], w1 = kn[2 * lane + 1];
    for (int u = vb; u < NBATCH * 16 * 8; u += nvb) {
        const int h = u & 7, j = (u >> 3) & 15, b = u >> 7;
        float m0 = 0.f, m1 = 0.f;
        for (int i = 0; i < 32; ++i) {
            unsigned* p = (unsigned*)(QKV + ((size_t)b * SEQ + j * 256 + wave * 32 + i) * ODN + 1024 + h * 128 + 2 * lane);
            const unsigned uu = *p; float k0 = bflo(uu), k1 = bfhi(uu);
            const float rs = rsqrtf(wave_sum(k0 * k0 + k1 * k1) * (1.f / 128.f) + RMS_EPS);
            k0 *= rs * w0; k1 *= rs * w1; m0 += k0; m1 += k1;
            *p = pk2(k0, k1);
        }
        red[wave * 128 + 2 * lane] = m0; red[wave * 128 + 2 * lane + 1] = m1;
        __syncthreads();
        if (tid < 128) { float s = 0.f;
#pragma unroll
            for (int w = 0; w < 8; ++w) s += red[w * 128 + tid];
            KM[(((size_t)b * 16 + j) * 8 + h) * 128 + tid] = s * (1.f / 256.f); }
        __syncthreads();
    }
}

__global__ void __launch_bounds__(512) k_prologue(Params P) { extern __shared__ __attribute__((aligned(16))) unsigned char lds[]; phase_prologue(P, lds, blockIdx.x, gridDim.x); }
__global__ void __launch_bounds__(512) k_norm(Params P, int mode, int layer, const float* xsrc, float* xdst, int clayer) {
    extern __shared__ __attribute__((aligned(16))) unsigned char lds[]; phase_norm(P, lds, blockIdx.x, gridDim.x, mode, layer, xsrc, xdst, clayer); }
__global__ void __launch_bounds__(512) k_kprep(Params P, int layer) { extern __shared__ __attribute__((aligned(16))) unsigned char lds[]; phase_kprep(P, lds, blockIdx.x, gridDim.x, layer); }

template <int EPI  >
__global__ void __launch_bounds__(256) k_gemm_naive(const bf16* A, int lda, const float* W, int ldw, int K, int N, bf16* Ob, int ldc, const float* xin, float* xout, const float* gate) {
    const int col = (blockIdx.x * 64 + threadIdx.x) * 4, r0 = blockIdx.y * 16 + threadIdx.y * 4;
    if (col >= N) return;
    f32x4 acc[4];
#pragma unroll
    for (int i = 0; i < 4; ++i) acc[i] = (f32x4){0.f, 0.f, 0.f, 0.f};
    const bf16* a0 = A + (size_t)r0 * lda;
    for (int k = 0; k < K; ++k) {
        const f32x4 w = *(const f32x4*)(W + (size_t)k * ldw + col);
#pragma unroll
        for (int i = 0; i < 4; ++i) acc[i] += w * bf2f(a0[(size_t)i * lda + k]);
    }
#pragma unroll
    for (int i = 0; i < 4; ++i) {
        const int r = r0 + i;
        if (EPI == 0) { u32x2 o; o.x = pk2(acc[i].x, acc[i].y); o.y = pk2(acc[i].z, acc[i].w); *(u32x2*)(Ob + (size_t)r * ldc + col) = o; }
        else { const f32x4 g = *(const f32x4*)(gate + (size_t)(r >> 12) * (6 * DM) + col); const f32x4 xi = *(const f32x4*)(xin + (size_t)r * DM + col);
            *(f32x4*)(xout + (size_t)r * DM + col) = xi + g * acc[i]; }
    }
}
__global__ void __launch_bounds__(256) k_moe_up_naive(Params P, int layer) {
    const int col = (blockIdx.x * 64 + threadIdx.x) * 4, r0 = blockIdx.y * 16 + threadIdx.y * 4;
    const unsigned* cnt = (const unsigned*)(P.ws + WS_CTL) + CW_CNT + layer * 32;
    int e = -1, base = 0;
    { int a = 0; for (int i = 0; i < NEXP; ++i) { const int pc = ((int)cnt[i] + 255) & ~255; if (r0 >= a && r0 < a + pc) { e = i; base = a; } a += pc; } }
    if (e < 0) return;
    const int n = (int)cnt[e]; const int* LIST = (const int*)(P.ws + WS_LIST) + (size_t)e * NTOK;
    int tok[4]; bool ok[4];
#pragma unroll
    for (int i = 0; i < 4; ++i) { const int s = r0 + i - base; ok[i] = s < n; tok[i] = ok[i] ? (LIST[s] >> 1) : 0; }
    const bf16* H = (const bf16*)(P.ws + WS_H);
    const float* w1 = P.in[I_MW1] + ((size_t)layer * NEXP + e) * DM * MOEH + col; const float* w3 = P.in[I_MW3] + ((size_t)layer * NEXP + e) * DM * MOEH + col;
    f32x4 a1[4], a3[4];
#pragma unroll
    for (int i = 0; i < 4; ++i) { a1[i] = (f32x4){0.f, 0.f, 0.f, 0.f}; a3[i] = a1[i]; }
    for (int k = 0; k < DM; ++k) {
        const f32x4 u = *(const f32x4*)(w1 + (size_t)k * MOEH), w = *(const f32x4*)(w3 + (size_t)k * MOEH);
#pragma unroll
        for (int i = 0; i < 4; ++i) { const float hv = bf2f(H[(size_t)tok[i] * DM + k]); a1[i] += u * hv; a3[i] += w * hv; }
    }
    bf16* ACT = (bf16*)(P.ws + WS_ACT);
#pragma unroll
    for (int i = 0; i < 4; ++i) if (ok[i]) { u32x2 o; o.x = pk2(silu_f(a1[i].x) * a3[i].x, silu_f(a1[i].y) * a3[i].y); o.y = pk2(silu_f(a1[i].z) * a3[i].z, silu_f(a1[i].w) * a3[i].w);
        *(u32x2*)(ACT + (size_t)(r0 + i) * MOEH + col) = o; }
}
__global__ void __launch_bounds__(256) k_moe_down_naive(Params P, int layer) {
    const int col = (blockIdx.x * 64 + threadIdx.x) * 4, r0 = blockIdx.y * 16 + threadIdx.y * 4;
    const unsigned* cnt = (const unsigned*)(P.ws + WS_CTL) + CW_CNT + layer * 32;
    int e = -1, base = 0;
    { int a = 0; for (int i = 0; i < NEXP; ++i) { const int pc = ((int)cnt[i] + 255) & ~255; if (r0 >= a && r0 < a + pc) { e = i; base = a; } a += pc; } }
    if (e < 0) return;
    const int n = (int)cnt[e];
    if (r0 - base >= n) return;
    const bf16* ACT = (const bf16*)(P.ws + WS_ACT) + (size_t)r0 * MOEH;
    const float* w2 = P.in[I_MW2] + ((size_t)layer * NEXP + e) * MOEH * DM + col;
    f32x4 acc[4];
#pragma unroll
    for (int i = 0; i < 4; ++i) acc[i] = (f32x4){0.f, 0.f, 0.f, 0.f};
    for (int k = 0; k < MOEH; ++k) {
        const f32x4 w = *(const f32x4*)(w2 + (size_t)k * DM);
#pragma unroll
        for (int i = 0; i < 4; ++i) acc[i] += w * ((r0 + i - base < n) ? bf2f(ACT[(size_t)i * MOEH + k]) : 0.f);
    }
    bf16* YP = (bf16*)(P.ws + WS_YP);
#pragma unroll
    for (int i = 0; i < 4; ++i) if (r0 + i - base < n) { u32x2 o; o.x = pk2(acc[i].x, acc[i].y); o.y = pk2(acc[i].z, acc[i].w); *(u32x2*)(YP + (size_t)(r0 + i) * DM + col) = o; }
}
__global__ void __launch_bounds__(512) k_swa_naive(Params P, int layer) {
    __shared__ float qs[8][64];
    const int r = blockIdx.x, lane = threadIdx.x & 63, h = threadIdx.x >> 6, kvh = h >> 2, b = r >> 12, t = r & (SEQ - 1), jl = layer >> 1;
    const bf16* QKV = (const bf16*)(P.ws + WS_BIG); const float* BT = (const float*)(P.ws + WS_BT);
    { const float q = bf2f(QKV[(size_t)r * EVN + h * 64 + lane]); const float rs = rsqrtf(wave_sum(q * q) * (1.f / 64.f) + RMS_EPS);
      qs[h][lane] = q * rs * P.in[I_AQN][jl * 64 + lane] * P.in[I_AKN][jl * 64 + lane]; }
    __syncthreads();
    float lg[2];
#pragma unroll
    for (int i = 0; i < 2; ++i) { const int dist = i * 64 + lane, s = t - dist; lg[i] = -INFINITY;
        if (s >= 0) { const bf16* kr = QKV + ((size_t)b * SEQ + s) * EVN + 512 + kvh * 64; float dot = 0.f, kss = 0.f;
#pragma unroll 8
            for (int d = 0; d < 64; ++d) { const float kv = bf2f(kr[d]); dot += qs[h][d] * kv; kss += kv * kv; }
            lg[i] = dot * rsqrtf(kss * (1.f / 64.f) + RMS_EPS) * 0.125f + BT[h * 128 + dist]; } }
    const float sink = P.in[I_ASINK][jl * 8 + h];
    const float m = fmaxf(wave_max(fmaxf(lg[0], lg[1])), sink);
    float p[2];
#pragma unroll
    for (int i = 0; i < 2; ++i) p[i] = (lg[i] == -INFINITY) ? 0.f : __expf(lg[i] - m);
    const float den = wave_sum(p[0] + p[1]) + __expf(sink - m);
    float o = 0.f;
#pragma unroll
    for (int i = 0; i < 2; ++i)
        for (int src = 0; src < 64; ++src) { const float ps = __shfl(p[i], src); const int s = t - (i * 64 + src);
            if (s >= 0) o += ps * bf2f(QKV[((size_t)b * SEQ + s) * EVN + 640 + kvh * 64 + lane]); }
    ((bf16*)(P.ws + WS_MIX))[(size_t)r * DM + h * 64 + lane] = (bf16)f2bf(o / den);
}
__global__ void __launch_bounds__(256) k_gla_decay_naive(Params P, int layer) {
    const int r = blockIdx.x, c = threadIdx.x, jl = layer >> 1;
    const float* ab = (const float*)(P.ws + WS_AB) + (size_t)r * 16; const float* gu = P.in[I_BGU] + (size_t)jl * 16 * 256;
    float z = P.in[I_BGB][jl * 256 + c];
#pragma unroll
    for (int j = 0; j < 16; ++j) z += ab[j] * gu[j * 256 + c];
    ((float*)(P.ws + WS_UPD))[(size_t)r * 256 + c] = __expf(log_sigmoid_f(z) * (1.f / 16.f));
}
__global__ void __launch_bounds__(128) k_gla_scan_naive(Params P, int layer) {
    const int b = blockIdx.x >> 2, h = blockIdx.x & 3, dv = threadIdx.x;
    const bf16* QKV = (const bf16*)(P.ws + WS_BIG); const float* A = (const float*)(P.ws + WS_UPD); float* O = (float*)(P.ws + WS_SIN);
    float S[64];
#pragma unroll
    for (int d = 0; d < 64; ++d) S[d] = 0.f;
    for (int t = 0; t < SEQ; ++t) {
        const size_t r = (size_t)b * SEQ + t;
        const bf16* row = QKV + r * EVN; const float* ar = A + r * 256 + h * 64;
        const float v = bf2f(row[1280 + h * 128 + dv]);
        float o = 0.f;
#pragma unroll
        for (int d = 0; d < 64; ++d) { S[d] = ar[d] * S[d] + bf2f(row[1024 + h * 64 + d]) * v; o += bf2f(row[768 + h * 64 + d]) * S[d]; }
        O[r * 512 + h * 128 + dv] = o * 0.125f;
    }
}
__global__ void __launch_bounds__(256) k_gla_fin_naive(Params P, int layer) {
    const int r = blockIdx.x, lane = threadIdx.x & 63, h = threadIdx.x >> 6, jl = layer >> 1;
    const float* O = (const float*)(P.ws + WS_SIN) + (size_t)r * 512 + h * 128 + 2 * lane; const bf16* QKV = (const bf16*)(P.ws + WS_BIG);
    const float o0 = O[0], o1 = O[1]; const float rs = rsqrtf(wave_sum(o0 * o0 + o1 * o1) * (1.f / 128.f) + RMS_EPS);
    const unsigned g = *(const unsigned*)(QKV + (size_t)r * EVN + 1792 + h * 128 + 2 * lane);
    const float* on = P.in[I_BON] + jl * 128 + 2 * lane;
    *(unsigned*)((bf16*)(P.ws + WS_MIX) + (size_t)r * DM + 512 + h * 128 + 2 * lane) = pk2(o0 * rs * on[0] * silu_f(bflo(g)), o1 * rs * on[1] * silu_f(bfhi(g)));
}
__global__ void __launch_bounds__(512) k_moba_naive(Params P, int layer) {
    __shared__ float qs[8][128];
    const int r = blockIdx.x, lane = threadIdx.x & 63, h = threadIdx.x >> 6, b = r >> 12, t = r & (SEQ - 1), qblk = t >> 8, jl = layer >> 1;
    const bf16* QKV = (const bf16*)(P.ws + WS_BIG); const float* BT = (const float*)(P.ws + WS_BT) + h * 128; const float* KM = (const float*)(P.ws + WS_KMEAN);
    { const unsigned u = *(const unsigned*)(QKV + (size_t)r * ODN + h * 128 + 2 * lane); const float q0 = bflo(u), q1 = bfhi(u);
      const float rs = rsqrtf(wave_sum(q0 * q0 + q1 * q1) * (1.f / 128.f) + RMS_EPS); const float* qn = P.in[I_CQN] + jl * 128 + 2 * lane;
      qs[h][2 * lane] = q0 * rs * qn[0]; qs[h][2 * lane + 1] = q1 * rs * qn[1]; }
    __syncthreads();
    float sc = -INFINITY;
    if (lane < qblk) { const float* km = KM + (((size_t)b * 16 + lane) * 8 + h) * 128; float d = 0.f; for (int i = 0; i < 128; ++i) d += qs[h][i] * km[i]; sc = d; }
    int blk[4]; blk[0] = qblk;
#pragma unroll
    for (int n = 0; n < 3; ++n) { const float mx = wave_max(sc); const unsigned long long bal = __ballot(sc == mx && mx > -INFINITY);
        const int idx = bal ? (__ffsll((long long)bal) - 1) : -1; blk[1 + n] = idx; if (lane == idx) sc = -INFINITY; }
    float lg[4][4];
#pragma unroll
    for (int s = 0; s < 4; ++s)
#pragma unroll
        for (int rr = 0; rr < 4; ++rr) { lg[s][rr] = -INFINITY;
            if (blk[s] >= 0) { const int key = blk[s] * 256 + rr * 64 + lane, dist = t - key;
                if (dist >= 0) { const bf16* kr = QKV + ((size_t)b * SEQ + key) * ODN + 1024 + h * 128; float dot = 0.f;
#pragma unroll 8
                    for (int d = 0; d < 128; ++d) dot += qs[h][d] * bf2f(kr[d]);
                    lg[s][rr] = dot * 0.08838834764831845f + BT[dist < 127 ? dist : 127]; } } }
    float m = -INFINITY;
#pragma unroll
    for (int s = 0; s < 4; ++s)
#pragma unroll
        for (int rr = 0; rr < 4; ++rr) m = fmaxf(m, lg[s][rr]);
    m = wave_max(m);
    float den = 0.f;
#pragma unroll
    for (int s = 0; s < 4; ++s)
#pragma unroll
        for (int rr = 0; rr < 4; ++rr) { lg[s][rr] = (lg[s][rr] == -INFINITY) ? 0.f : __expf(lg[s][rr] - m); den += lg[s][rr]; }
    den = wave_sum(den);
    float o0 = 0.f, o1 = 0.f;
#pragma unroll
    for (int s = 0; s < 4; ++s)
#pragma unroll
        for (int rr = 0; rr < 4; ++rr) {
            if (blk[s] < 0) continue;
            for (int src = 0; src < 64; ++src) { const float ps = __shfl(lg[s][rr], src); const int key = blk[s] * 256 + rr * 64 + src;
                if (key <= t) { const unsigned u = *(const unsigned*)(QKV + ((size_t)b * SEQ + key) * ODN + 2048 + h * 128 + 2 * lane); o0 += ps * bflo(u); o1 += ps * bfhi(u); } } }
    *(unsigned*)((bf16*)(P.ws + WS_MIX) + (size_t)r * DM + h * 128 + 2 * lane) = pk2(o0 / den, o1 / den);
}

extern "C" void kernel_launch(void* const* d_in, const int* in_sizes, int n_in, void* d_out, int out_size, void* d_ws, size_t ws_size, hipStream_t stream) {
    static int ok = 0;
    constexpr int LDS_NORM = 147456 + 8192;
    if (ok == 0) {
        if (n_in != N_IN || out_size != NTOK * DM || ws_size < WS_END) { fprintf(stderr, "kernel_launch: unexpected shapes (n_in %d out %d ws %zu need %zu)\n", n_in, out_size, ws_size, (size_t)WS_END); ok = -1; return; }
        if (hipFuncSetAttribute((const void*)k_norm, hipFuncAttributeMaxDynamicSharedMemorySize, LDS_NORM) != hipSuccess) { fprintf(stderr, "kernel_launch: hipFuncSetAttribute failed\n"); ok = -1; return; }
        ok = 1;
    }
    if (ok < 0) return;
    Params P{};
    for (int i = 0; i < N_IN; ++i) P.in[i] = (const float*)d_in[i];
    P.out = (float*)d_out; P.ws = (unsigned char*)d_ws; P.ph_lo = 0; P.ph_hi = 0;
    hipMemsetAsync((char*)d_ws + WS_CTL, 0, CTL_BYTES, stream);
    const float* x_in = P.in[I_X]; float* X = P.out; float* MOD = (float*)(P.ws + WS_MOD);
    bf16* H = (bf16*)(P.ws + WS_H); bf16* QKV = (bf16*)(P.ws + WS_BIG); bf16* MIX = (bf16*)(P.ws + WS_MIX);
    hipLaunchKernelGGL(k_prologue, dim3(256), dim3(512), 49152, stream, P);
    for (int l = 0; l < DEPTH; ++l) {
        const int jl = l >> 1; const bool even = (l & 1) == 0;
        const float* xs = (l == 0) ? x_in : X;
        hipLaunchKernelGGL(k_norm, dim3(256), dim3(512), LDS_NORM, stream, P, even ? 1 : 2, l, xs, X, l == 0 ? -1 : l - 1);
        if (even) hipLaunchKernelGGL((k_gemm_naive<0>), dim3(EVN / 256, NTOK / 16), dim3(64, 4), 0, stream, H, DM, P.in[I_EWIN] + (size_t)jl * DM * EVEN_IN, EVEN_IN, DM, EVN, QKV, EVN, nullptr, nullptr, nullptr);
        else hipLaunchKernelGGL((k_gemm_naive<0>), dim3(ODN / 256, NTOK / 16), dim3(64, 4), 0, stream, H, DM, P.in[I_OWIN] + (size_t)jl * DM * ODN, ODN, DM, ODN, QKV, ODN, nullptr, nullptr, nullptr);
        if (even) {
            hipLaunchKernelGGL(k_swa_naive, dim3(NTOK), dim3(512), 0, stream, P, l);
            hipLaunchKernelGGL(k_gla_decay_naive, dim3(NTOK), dim3(256), 0, stream, P, l);
            hipLaunchKernelGGL(k_gla_scan_naive, dim3(32), dim3(128), 0, stream, P, l);
            hipLaunchKernelGGL(k_gla_fin_naive, dim3(NTOK), dim3(256), 0, stream, P, l);
        } else {
            hipLaunchKernelGGL(k_kprep, dim3(256), dim3(512), 4096, stream, P, l);
            hipLaunchKernelGGL(k_moba_naive, dim3(NTOK), dim3(512), 0, stream, P, l);
        }
        hipLaunchKernelGGL((k_gemm_naive<1>), dim3(DM / 256, NTOK / 16), dim3(64, 4), 0, stream, MIX, DM, (even ? P.in[I_EWOUT] : P.in[I_OWOUT]) + (size_t)jl * DM * DM, DM, DM, DM, nullptr, 0, xs, X, MOD + (size_t)l * NBATCH * 6 * DM + 2 * DM);
        hipLaunchKernelGGL(k_norm, dim3(256), dim3(512), LDS_NORM, stream, P, 3, l, (const float*)X, (float*)nullptr, -1);
        hipLaunchKernelGGL(k_moe_up_naive, dim3(2, MOE_ROWS / 16), dim3(64, 4), 0, stream, P, l);
        hipLaunchKernelGGL(k_moe_down_naive, dim3(4, MOE_ROWS / 16), dim3(64, 4), 0, stream, P, l);
    }
    hipLaunchKernelGGL(k_norm, dim3(256), dim3(512), LDS_NORM, stream, P, 0, 0, (const float*)X, X, DEPTH - 1);
}
```

```cpp
#include <hip/hip_runtime.h>
#include <cstdio>
#include <cstdint>

#define DEV __device__ __forceinline__
typedef unsigned short bf16;
typedef float f32x4 __attribute__((ext_vector_type(4)));
typedef float f32x2 __attribute__((ext_vector_type(2)));
typedef unsigned u32x2 __attribute__((ext_vector_type(2)));
typedef unsigned u32x4 __attribute__((ext_vector_type(4)));

constexpr int DM = 1024, NBATCH = 8, SEQ = 4096, NTOK = NBATCH * SEQ, DEPTH = 4;
constexpr int EVEN_IN = 2320, EVN = 2304, ODN = 3072;
constexpr int NEXP = 32, MOEH = 512, NPAIR = 2 * NTOK, MOE_ROWS = 73728;
constexpr float RMS_EPS = 1e-6f;
enum { I_X = 0, I_C, I_RELB, I_ADAW, I_ADAB, I_N1W, I_N2W, I_EWIN, I_EWOUT, I_AQN, I_AKN, I_ASINK, I_BGU, I_BGB, I_BON, I_OWIN, I_OWOUT, I_CQN, I_CKN,
       I_MWG, I_MBG, I_MWE, I_MBE, I_MW1, I_MW3, I_MW2, N_IN };
struct Params { const float* in[N_IN]; float* out; unsigned char* ws; int ph_lo, ph_hi, li, pad; };

constexpr size_t al256(size_t x) { return (x + 255) & ~(size_t)255; }
constexpr size_t WS_CTL = 0, CTL_BYTES = 1u << 20;
constexpr size_t WS_MOD = WS_CTL + CTL_BYTES;
constexpr size_t WS_BT = WS_MOD + al256((size_t)DEPTH * NBATCH * 6 * DM * 4);
constexpr size_t WS_KMEAN = WS_BT + al256(8 * 128 * 4);
constexpr size_t WS_AB = WS_KMEAN + al256((size_t)NBATCH * 16 * 8 * 128 * 4);
constexpr size_t WS_PAIRE = WS_AB + al256((size_t)NTOK * 16 * 4);
constexpr size_t WS_PAIRS = WS_PAIRE + al256((size_t)NPAIR * 4);
constexpr size_t WS_PAIRG = WS_PAIRS + al256((size_t)NPAIR * 4);
constexpr size_t WS_LIST = WS_PAIRG + al256((size_t)NPAIR * 4);
constexpr size_t WS_WEI = WS_LIST + al256((size_t)NEXP * NTOK * 4);
constexpr size_t WS_WEO = WS_WEI + al256((size_t)2 * EVN * DM * 2);
constexpr size_t WS_WOI = WS_WEO + al256((size_t)2 * DM * DM * 2);
constexpr size_t WS_WOO = WS_WOI + al256((size_t)2 * ODN * DM * 2);
constexpr size_t WS_WUP = WS_WOO + al256((size_t)2 * DM * DM * 2);
constexpr size_t WS_WDN = WS_WUP + al256((size_t)DEPTH * NEXP * 1024 * DM * 2);
constexpr size_t WS_H = WS_WDN + al256((size_t)DEPTH * NEXP * DM * MOEH * 2);
constexpr size_t WS_MIX = WS_H + al256((size_t)NTOK * DM * 2);
constexpr size_t WS_UPD = WS_MIX + al256((size_t)NTOK * DM * 2);
constexpr size_t WS_SIN = WS_UPD + al256((size_t)2048 * 64 * 128 * 4);
constexpr size_t WS_DEC = WS_SIN + al256((size_t)2048 * 64 * 128 * 4);
constexpr size_t WS_BIG = WS_DEC + al256((size_t)2048 * 64 * 4);
constexpr size_t WS_ACT = WS_BIG, WS_YP = WS_BIG + al256((size_t)MOE_ROWS * MOEH * 2);
constexpr size_t BIG_BYTES = al256((size_t)MOE_ROWS * MOEH * 2) + al256((size_t)MOE_ROWS * DM * 2);
static_assert(BIG_BYTES >= (size_t)NTOK * ODN * 2, "QKV fits the union");
constexpr size_t WS_END = WS_BIG + BIG_BYTES;
constexpr int CW_CNT = 64;
constexpr int CW_BAR = 4096;

__device__ const unsigned char REL_BUCKET[128] = {0,1,2,3,4,5,6,7,8,9,10,11,12,13,14,15,16,16,16,17,17,18,18,18,19,19,19,20,20,20,20,21,21,21,21,22,22,22,22,22,23,23,23,23,23,23,24,24,24,24,24,24,25,25,25,25,25,25,25,26,26,26,26,26,26,26,26,27,27,27,27,27,27,27,27,27,27,28,28,28,28,28,28,28,28,28,28,29,29,29,29,29,29,29,29,29,29,29,29,30,30,30,30,30,30,30,30,30,30,30,30,30,30,31,31,31,31,31,31,31,31,31,31,31,31,31,31,31};

DEV int opaque_tid() { int t = threadIdx.x; asm volatile("" : "+v"(t)); return t; }
DEV float bf2f(bf16 v) { return __uint_as_float((unsigned)v << 16); }
DEV float bflo(unsigned u) { return __uint_as_float(u << 16); }
DEV float bfhi(unsigned u) { return __uint_as_float(u & 0xffff0000u); }
DEV unsigned f2bf(float f) { unsigned u = __float_as_uint(f); return (u + 0x7fffu + ((u >> 16) & 1u)) >> 16; }
DEV unsigned pk2(float lo, float hi) { return f2bf(lo) | (f2bf(hi) << 16); }
DEV float wave_sum(float v) {
#pragma unroll
    for (int o = 1; o < 64; o <<= 1) v += __shfl_xor(v, o);
    return v;
}
DEV float wave_max(float v) {
#pragma unroll
    for (int o = 1; o < 64; o <<= 1) v = fmaxf(v, __shfl_xor(v, o));
    return v;
}
DEV float silu_f(float x) { return x / (1.f + __expf(-x)); }
DEV float log_sigmoid_f(float x) { return fminf(x, 0.f) - log1pf(__expf(-fabsf(x))); }
DEV void moe_rowbase(const unsigned* cnt, int* rb  ) { int a = 0; for (int e = 0; e < NEXP; ++e) { rb[e] = a; a += ((int)cnt[e] + 255) & ~255; } rb[NEXP] = a; }

DEV void phase_prologue(const Params& P, unsigned char* lds, int vb, int nvb, bool with_weights) {
    const int tid = opaque_tid(), lane = tid & 63, wave = tid >> 6;
    float* cond = (float*)lds;
    float* red = (float*)(lds + 32768);
    const float* c = P.in[I_C];
    for (int i = tid; i < NBATCH * DM; i += 512) cond[i] = silu_f(c[i]);
    __syncthreads();
    float* MOD = (float*)(P.ws + WS_MOD);
    const float* adaw = P.in[I_ADAW]; const float* adab = P.in[I_ADAB];
    for (int u = vb; u < DEPTH * 96; u += nvb) {
        const int l = u / 96, col = (u % 96) * 64 + lane;
        float acc[8];
#pragma unroll
        for (int b = 0; b < 8; ++b) acc[b] = 0.f;
        const float* wp = adaw + ((size_t)l * DM + wave * 128) * (6 * DM) + col;
#pragma unroll 4
        for (int k = 0; k < 128; ++k) {
            const float w = wp[(size_t)k * (6 * DM)];
#pragma unroll
            for (int b = 0; b < 8; ++b) acc[b] += cond[b * DM + wave * 128 + k] * w;
        }
#pragma unroll
        for (int b = 0; b < 8; ++b) red[(wave * 8 + b) * 64 + lane] = acc[b];
        __syncthreads();
        {
            float s = 0.f;
#pragma unroll
            for (int w = 0; w < 8; ++w) s += red[(w * 8 + wave) * 64 + lane];
            MOD[((size_t)l * NBATCH + wave) * (6 * DM) + col] = s + adab[(size_t)l * 6 * DM + col];
        }
        __syncthreads();
    }
    if (vb == 0) {
        float* BT = (float*)(P.ws + WS_BT); const float* rb = P.in[I_RELB];
        for (int i = tid; i < 8 * 128; i += 512) { const int h = i >> 7, d = i & 127; BT[i] = rb[REL_BUCKET[d] * 8 + h]; }
    }
    if (!with_weights) return;
    float* scr = (float*)(lds + 49152 + wave * 8448);
    constexpr int IT_EI = 2 * 16 * 72, IT_EO = 2 * 16 * 32, IT_OI = 2 * 16 * 96, IT_OO = 2 * 16 * 32, IT_W = DEPTH * NEXP * 256;
    constexpr int NITEMS = IT_EI + IT_EO + IT_OI + IT_OO + 3 * IT_W;
    for (int it = vb * 8 + wave; it < NITEMS; it += nvb * 8) {
        int r = it; const float* W; int ldw, k0, n0, K = DM, drow0; bf16* WT;
        if (r < IT_EI) { const int jl = r / 1152, rr = r % 1152; k0 = (rr / 72) * 64; n0 = (rr % 72) * 32; W = P.in[I_EWIN] + (size_t)jl * DM * EVEN_IN; ldw = EVEN_IN; WT = (bf16*)(P.ws + WS_WEI) + (size_t)jl * EVN * DM; drow0 = n0; }
        else if ((r -= IT_EI) < IT_EO) { const int jl = r / 512, rr = r % 512; k0 = (rr / 32) * 64; n0 = (rr % 32) * 32; W = P.in[I_EWOUT] + (size_t)jl * DM * DM; ldw = DM; WT = (bf16*)(P.ws + WS_WEO) + (size_t)jl * DM * DM; drow0 = n0; }
        else if ((r -= IT_EO) < IT_OI) { const int jl = r / 1536, rr = r % 1536; k0 = (rr / 96) * 64; n0 = (rr % 96) * 32; W = P.in[I_OWIN] + (size_t)jl * DM * ODN; ldw = ODN; WT = (bf16*)(P.ws + WS_WOI) + (size_t)jl * ODN * DM; drow0 = n0; }
        else if ((r -= IT_OI) < IT_OO) { const int jl = r / 512, rr = r % 512; k0 = (rr / 32) * 64; n0 = (rr % 32) * 32; W = P.in[I_OWOUT] + (size_t)jl * DM * DM; ldw = DM; WT = (bf16*)(P.ws + WS_WOO) + (size_t)jl * DM * DM; drow0 = n0; }
        else if ((r -= IT_OO) < 2 * IT_W) { const int w3 = r >= IT_W; if (w3) r -= IT_W; const int le = r >> 8, rr = r & 255; k0 = (rr >> 4) * 64; n0 = (rr & 15) * 32;
            W = P.in[w3 ? I_MW3 : I_MW1] + (size_t)le * DM * MOEH; ldw = MOEH; WT = (bf16*)(P.ws + WS_WUP) + (size_t)le * 1024 * DM; drow0 = (n0 >> 7) * 256 + (n0 & 127) + (w3 ? 128 : 0); }
        else { r -= 2 * IT_W; const int le = r >> 8, rr = r & 255; k0 = (rr >> 5) * 64; n0 = (rr & 31) * 32; W = P.in[I_MW2] + (size_t)le * MOEH * DM; ldw = DM; K = MOEH; WT = (bf16*)(P.ws + WS_WDN) + (size_t)le * DM * MOEH; drow0 = n0; }
#pragma unroll 8
        for (int i = 0; i < 32; ++i) { const int kk = 2 * i + (lane >> 5); scr[kk * 33 + (lane & 31)] = W[(size_t)(k0 + kk) * ldw + n0 + (lane & 31)]; }
        asm volatile("s_waitcnt lgkmcnt(0)" ::: "memory");
        const int c = lane & 7;
#pragma unroll
        for (int j = 0; j < 4; ++j) { const int n = (lane >> 3) + 8 * j; const float* s = scr + (8 * c) * 33 + n;
            u32x4 o; o.x = pk2(s[0 * 33], s[1 * 33]); o.y = pk2(s[2 * 33], s[3 * 33]); o.z = pk2(s[4 * 33], s[5 * 33]); o.w = pk2(s[6 * 33], s[7 * 33]);
            *(u32x4*)(WT + (size_t)(drow0 + n) * K + k0 + 8 * c) = o; }
        asm volatile("s_waitcnt lgkmcnt(0)" ::: "memory");
    }
}

DEV void phase_norm(const Params& P, unsigned char* lds, int vb, int nvb, int mode, int layer, const float* xsrc, float* xdst, int clayer  ) {
    const int tid = opaque_tid(), lane = tid & 63, wave = tid >> 6;
    float* tab = (float*)lds;
    int* lcnt = (int*)(lds + 147456);
    int* lbase = lcnt + 32;
    int* rowb = lbase + 32;
    int* plist = rowb + 64;
    int* pn = plist + 512;
    const unsigned* ctl = (const unsigned*)(P.ws + WS_CTL);
    float* MOD = (float*)(P.ws + WS_MOD);
    if (mode == 1) { const float* w = P.in[I_EWIN] + (size_t)(layer >> 1) * DM * EVEN_IN;
        for (int i = tid; i < DM * 16; i += 512) { const int k = i >> 4, j = i & 15; tab[j * DM + k] = w[(size_t)k * EVEN_IN + EVN + j]; } }
    if (mode == 3) { const float* wg = P.in[I_MWG] + (size_t)layer * DM * 4; const float* we = P.in[I_MWE] + (size_t)layer * DM * 32;
        for (int i = tid; i < DM * 4; i += 512) { const int k = i >> 2, j = i & 3; tab[j * DM + k] = wg[i]; }
        for (int i = tid; i < DM * 32; i += 512) { const int k = i >> 5, j = i & 31; tab[(4 + j) * DM + k] = we[i]; }
        if (tid < 32) lcnt[tid] = 0; if (tid == 0) pn[0] = 0; }
    if (clayer >= 0 && tid == 0) moe_rowbase(ctl + CW_CNT + clayer * 32, rowb);
    __syncthreads();
    const int* PE = (const int*)(P.ws + WS_PAIRE); const int* PS = (const int*)(P.ws + WS_PAIRS); const float* PG = (const float*)(P.ws + WS_PAIRG);
    const bf16* YP = (const bf16*)(P.ws + WS_YP);
    bf16* H = (bf16*)(P.ws + WS_H);
    for (int r = vb * 8 + wave; r < NTOK; r += nvb * 8) {
        const int b = r >> 12;
        f32x4 v[4];
#pragma unroll
        for (int j = 0; j < 4; ++j) v[j] = *(const f32x4*)(xsrc + (size_t)r * DM + j * 256 + lane * 4);
        if (clayer >= 0) {
            const int e0 = PE[2 * r], e1 = PE[2 * r + 1]; const float g0 = PG[2 * r], g1 = PG[2 * r + 1];
            const size_t p0 = (size_t)(rowb[e0] + PS[2 * r]), p1 = (size_t)(rowb[e1] + PS[2 * r + 1]);
            const float* gate2 = MOD + ((size_t)clayer * NBATCH + b) * (6 * DM) + 5 * DM;
#pragma unroll
            for (int j = 0; j < 4; ++j) {
                const u32x2 y0 = *(const u32x2*)(YP + p0 * DM + j * 256 + lane * 4), y1 = *(const u32x2*)(YP + p1 * DM + j * 256 + lane * 4);
                const f32x4 g = *(const f32x4*)(gate2 + j * 256 + lane * 4);
                f32x4 m;
                m.x = g0 * bflo(y0.x) + g1 * bflo(y1.x); m.y = g0 * bfhi(y0.x) + g1 * bfhi(y1.x);
                m.z = g0 * bflo(y0.y) + g1 * bflo(y1.y); m.w = g0 * bfhi(y0.y) + g1 * bfhi(y1.y);
                v[j] = v[j] + g * m;
                if (xdst) *(f32x4*)(xdst + (size_t)r * DM + j * 256 + lane * 4) = v[j];
            }
        }
        if (mode == 0) continue;
        float ss = 0.f;
#pragma unroll
        for (int j = 0; j < 4; ++j) ss += (v[j].x * v[j].x + v[j].y * v[j].y) + (v[j].z * v[j].z + v[j].w * v[j].w);
        const float rstd = rsqrtf(wave_sum(ss) * (1.f / DM) + RMS_EPS);
        const float* nw = P.in[mode == 3 ? I_N2W : I_N1W] + (size_t)layer * DM;
        const float* modr = MOD + ((size_t)layer * NBATCH + b) * (6 * DM) + (mode == 3 ? 3 * DM : 0);
#pragma unroll
        for (int j = 0; j < 4; ++j) {
            const int c0 = j * 256 + lane * 4;
            const f32x4 w = *(const f32x4*)(nw + c0), sh = *(const f32x4*)(modr + c0), sc = *(const f32x4*)(modr + DM + c0);
            v[j] = (v[j] * rstd * w) * (sc + 1.f) + sh;
            u32x2 o; o.x = pk2(v[j].x, v[j].y); o.y = pk2(v[j].z, v[j].w);
            *(u32x2*)(H + (size_t)r * DM + c0) = o;
        }
        if (mode == 1) {
            float mine = 0.f;
#pragma unroll 2
            for (int q = 0; q < 16; ++q) { float a = 0.f;
#pragma unroll
                for (int j = 0; j < 4; ++j) { const f32x4 t = *(const f32x4*)(tab + q * DM + j * 256 + lane * 4); a += (v[j].x * t.x + v[j].y * t.y) + (v[j].z * t.z + v[j].w * t.w); }
                a = wave_sum(a); mine = (lane == q) ? a : mine; }
            if (lane < 16) ((float*)(P.ws + WS_AB))[(size_t)r * 16 + lane] = mine;
        }
        if (mode == 3) {
            float mine = 0.f;
#pragma unroll 2
            for (int q = 0; q < 36; ++q) { float a = 0.f;
#pragma unroll
                for (int j = 0; j < 4; ++j) { const f32x4 t = *(const f32x4*)(tab + q * DM + j * 256 + lane * 4); a += (v[j].x * t.x + v[j].y * t.y) + (v[j].z * t.z + v[j].w * t.w); }
                a = wave_sum(a); mine = (lane == q) ? a : mine; }
            { const float* bg = P.in[I_MBG] + layer * 4; const float* be = P.in[I_MBE] + layer * 32;
              if (lane < 4) mine += bg[lane]; else if (lane < 36) mine += be[lane - 4]; }
            float gl[4];
#pragma unroll
            for (int i = 0; i < 4; ++i) gl[i] = __shfl(mine, i);
            int g = 0; float gm = gl[0];
#pragma unroll
            for (int i = 1; i < 4; ++i) if (gl[i] > gm) { gm = gl[i]; g = i; }
            float den = 0.f;
#pragma unroll
            for (int i = 0; i < 4; ++i) den += __expf(gl[i] - gm);
            const float pg = 1.f / den;
            float el[8];
#pragma unroll
            for (int i = 0; i < 8; ++i) el[i] = __shfl(mine, 4 + g * 8 + i);
            int i1 = 0; float v1 = el[0];
#pragma unroll
            for (int i = 1; i < 8; ++i) if (el[i] > v1) { v1 = el[i]; i1 = i; }
            int i2 = -1; float v2 = -INFINITY;
#pragma unroll
            for (int i = 0; i < 8; ++i) if (i != i1 && el[i] > v2) { v2 = el[i]; i2 = i; }
            const float t2 = __expf(v2 - v1), w1 = 1.f / (1.f + t2), w2 = t2 * w1;
            if (lane == 0) {
                const int ea = g * 8 + i1, eb = g * 8 + i2;
                int* PEw = (int*)(P.ws + WS_PAIRE); float* PGw = (float*)(P.ws + WS_PAIRG);
                PEw[2 * r] = ea; PEw[2 * r + 1] = eb; PGw[2 * r] = pg * w1; PGw[2 * r + 1] = pg * w2;
                const int sa = atomicAdd(&lcnt[ea], 1), sb = atomicAdd(&lcnt[eb], 1);
                const int ix = atomicAdd(&pn[0], 2);
                plist[2 * ix] = 2 * r; plist[2 * ix + 1] = (ea << 16) | sa; plist[2 * ix + 2] = 2 * r + 1; plist[2 * ix + 3] = (eb << 16) | sb;
            }
        }
    }
    if (mode == 3) {
        __syncthreads();
        unsigned* cnt = (unsigned*)(P.ws + WS_CTL) + CW_CNT + layer * 32;
        if (tid < 32) lbase[tid] = (int)__hip_atomic_fetch_add(cnt + tid, (unsigned)lcnt[tid], __ATOMIC_RELAXED, __HIP_MEMORY_SCOPE_AGENT);
        __syncthreads();
        int* LIST = (int*)(P.ws + WS_LIST); int* PSw = (int*)(P.ws + WS_PAIRS);
        const int n = pn[0];
        for (int i = tid; i < n; i += 512) { const int pair = plist[2 * i], es = plist[2 * i + 1], e = es >> 16, slot = lbase[e] + (es & 0xffff);
            LIST[(size_t)e * NTOK + slot] = pair; PSw[pair] = slot; }
    }
}

DEV void phase_kprep(const Params& P, unsigned char* lds, int vb, int nvb, int layer) {
    const int tid = opaque_tid(), lane = tid & 63, wave = tid >> 6;
    float* red = (float*)lds;
    bf16* QKV = (bf16*)(P.ws + WS_BIG); float* KM = (float*)(P.ws + WS_KMEAN);
    const float* kn = P.in[I_CKN] + (layer >> 1) * 128;
    const float w0 = kn[2 * lane], w1 = kn[2 * lane + 1];
    for (int u = vb; u < NBATCH * 16 * 8; u += nvb) {
        const int h = u & 7, j = (u >> 3) & 15, b = u >> 7;
        float m0 = 0.f, m1 = 0.f;
        for (int i = 0; i < 32; ++i) {
            unsigned* p = (unsigned*)(QKV + ((size_t)b * SEQ + j * 256 + wave * 32 + i) * ODN + 1024 + h * 128 + 2 * lane);
            const unsigned uu = *p; float k0 = bflo(uu), k1 = bfhi(uu);
            const float rs = rsqrtf(wave_sum(k0 * k0 + k1 * k1) * (1.f / 128.f) + RMS_EPS);
            k0 *= rs * w0; k1 *= rs * w1; m0 += k0; m1 += k1;
            *p = pk2(k0, k1);
        }
        red[wave * 128 + 2 * lane] = m0; red[wave * 128 + 2 * lane + 1] = m1;
        __syncthreads();
        if (tid < 128) { float s = 0.f;
#pragma unroll
            for (int w = 0; w < 8; ++w) s += red[w * 128 + tid];
            KM[(((size_t)b * 16 + j) * 8 + h) * 128 + tid] = s * (1.f / 256.f); }
        __syncthreads();
    }
}

__global__ void __launch_bounds__(512) k_prologue(Params P) { extern __shared__ __attribute__((aligned(16))) unsigned char lds[]; phase_prologue(P, lds, blockIdx.x, gridDim.x, false); }
__global__ void __launch_bounds__(512) k_norm(Params P, int mode, int layer, const float* xsrc, float* xdst, int clayer) {
    extern __shared__ __attribute__((aligned(16))) unsigned char lds[]; phase_norm(P, lds, blockIdx.x, gridDim.x, mode, layer, xsrc, xdst, clayer); }
__global__ void __launch_bounds__(512) k_kprep(Params P, int layer) { extern __shared__ __attribute__((aligned(16))) unsigned char lds[]; phase_kprep(P, lds, blockIdx.x, gridDim.x, layer); }

namespace pg8 {
#define PG8_LAS __attribute__((address_space(3)))
typedef unsigned short bf16_t;
typedef short bf16x8 __attribute__((ext_vector_type(8)));
constexpr int BM = 256, BK = 64, HALF = 128, HTB = HALF * BK * 2  , STAGE_BYTES = 8 * HTB, NXCD = 8, WGM = 8;
__host__ __device__ __forceinline__ int lds_byte(int r, int c) { const int st = (r >> 4) * 2 + (c >> 5), rr = r & 15, cc = c & 31, ob = rr * 64 + cc * 2; return st * 1024 + (ob ^ (((ob >> 9) & 1) << 5)); }
__host__ __device__ __forceinline__ void stage_rc(int b, int& R, int& C) { const int st = b / 1024, sb = b % 1024, swz = sb ^ (((sb >> 9) & 1) << 5); R = (st >> 1) * 16 + swz / 64; C = (st & 1) * 32 + (swz % 64) / 2; }
__host__ __device__ __forceinline__ int perm32(int rho) { const int n = rho >> 4, i = rho & 15; return 8 * (i >> 2) + 4 * n + (i & 3); }

struct Unit { int pm, pn, bsel, aux; };
struct Gemm { const bf16_t* A; const bf16_t* Bt; int K; size_t bstride; };

struct StaticOrder {
    static constexpr bool GATHER = false;
    PG8_LAS int* tokl; int nM, nN, nwg, G, c;
    __device__ void init(int M, int N, int G_, int c_) { nM = M / BM; nN = N / BM; nwg = nM * nN; G = G_; c = c_; }
    __device__ bool next(int i, Unit& u) const {
        const long L = (long)i * G + c; if (L >= nwg) return false;
        int wgid = (int)L; { const int q = nwg / NXCD, r = nwg % NXCD, xcd = wgid % NXCD, off = wgid / NXCD; wgid = (xcd < r ? xcd * (q + 1) : r * (q + 1) + (xcd - r) * q) + off; }
        const int nig = WGM * nN, gid = wgid / nig, fm = gid * WGM, gsz = (nM - fm) < WGM ? (nM - fm) : WGM;
        u.pm = fm + ((wgid % nig) % gsz); u.pn = (wgid % nig) / gsz; u.bsel = 0; u.aux = 0; return true;
    }
    __device__ __forceinline__ int src_row(const Unit&, int) const { return 0; }
};
template <bool GATHER_> struct MoeOrder {
    static constexpr bool GATHER = GATHER_;
    const PG8_LAS int* tp; const PG8_LAS unsigned* cnt; const int* list; PG8_LAS int* tokl; int nN, G, c;
    __device__ bool next(int i, Unit& u) const {
        const int L = i * G + c; const int rt = L / nN; if (rt >= tp[NEXP]) return false;
        int e = 0;
#pragma unroll 1
        for (int k = 1; k < NEXP; ++k) e = (rt >= tp[k]) ? k : e;
        u.pm = rt; u.pn = L - rt * nN; u.bsel = e; u.aux = rt - tp[e]; return true;
    }
    __device__ __forceinline__ int src_row(const Unit& u, int r) const { const int s = u.aux * BM + r; return s < (int)cnt[u.bsel] ? (list[(size_t)u.bsel * NTOK + s] >> 1) : 0; }
};

__device__ __forceinline__ unsigned cvt_pk_bf16(float lo, float hi) { unsigned r; asm volatile("v_cvt_pk_bf16_f32 %0, %1, %2" : "=v"(r) : "v"(lo), "v"(hi)); return r; }
struct EpiBf16 {
    static constexpr bool PERM = true;
    bf16_t* O; int ldc;
    __device__ __forceinline__ void operator()(const f32x4 (&acc)[2][2][4][2], const Unit& u, int wr, int wc, int fr, int fq) const {
        const int row0 = u.pm * BM + wr * 64 + fr, col0 = u.pn * BM + wc * 32 + 8 * fq;
#pragma unroll
        for (int ai = 0; ai < 2; ++ai)
#pragma unroll
            for (int m = 0; m < 4; ++m) { bf16_t* rowp = O + (size_t)(row0 + ai * HALF + m * 16) * ldc + col0;
#pragma unroll
                for (int bj = 0; bj < 2; ++bj) { const f32x4 v0 = acc[ai][bj][m][0], v1 = acc[ai][bj][m][1];
                    u32x4 w; w.x = cvt_pk_bf16(v0[0], v0[1]); w.y = cvt_pk_bf16(v0[2], v0[3]); w.z = cvt_pk_bf16(v1[0], v1[1]); w.w = cvt_pk_bf16(v1[2], v1[3]);
                    *(u32x4*)(rowp + bj * HALF) = w; } }
    }
};
struct EpiResid {
    static constexpr bool PERM = false;
    const float* xin; float* xout; const float* gate;
    __device__ __forceinline__ void operator()(const f32x4 (&acc)[2][2][4][2], const Unit& u, int wr, int wc, int fr, int fq) const {
        const int row0 = u.pm * BM + wr * 64 + fr, col0 = u.pn * BM + wc * 32 + 4 * fq;
        const float* gr = gate + (size_t)((u.pm * BM) >> 12) * (6 * DM) + col0;
        f32x4 gv[2][2];
#pragma unroll
        for (int bj = 0; bj < 2; ++bj)
#pragma unroll
            for (int n = 0; n < 2; ++n) gv[bj][n] = *(const f32x4*)(gr + bj * HALF + n * 16);
#pragma unroll
        for (int ai = 0; ai < 2; ++ai)
#pragma unroll
            for (int m = 0; m < 4; ++m) { const size_t off = (size_t)(row0 + ai * HALF + m * 16) * DM + col0;
#pragma unroll
                for (int bj = 0; bj < 2; ++bj)
#pragma unroll
                    for (int n = 0; n < 2; ++n) { const f32x4 xi = *(const f32x4*)(xin + off + bj * HALF + n * 16); *(f32x4*)(xout + off + bj * HALF + n * 16) = xi + gv[bj][n] * acc[ai][bj][m][n]; } }
    }
};
struct EpiSiluMul {
    static constexpr bool PERM = true;
    bf16_t* O;
    __device__ __forceinline__ void operator()(const f32x4 (&acc)[2][2][4][2], const Unit& u, int wr, int wc, int fr, int fq) const {
        const int row0 = u.pm * BM + wr * 64 + fr, col0 = u.pn * HALF + wc * 32 + 8 * fq;
#pragma unroll
        for (int ai = 0; ai < 2; ++ai)
#pragma unroll
            for (int m = 0; m < 4; ++m) { bf16_t* rowp = O + (size_t)(row0 + ai * HALF + m * 16) * MOEH + col0;
                float o[8];
#pragma unroll
                for (int n = 0; n < 2; ++n)
#pragma unroll
                    for (int j = 0; j < 4; ++j) { const float a = acc[ai][0][m][n][j], b = acc[ai][1][m][n][j]; o[n * 4 + j] = a * __builtin_amdgcn_rcpf(1.f + __expf(-a)) * b; }
                u32x4 w; w.x = cvt_pk_bf16(o[0], o[1]); w.y = cvt_pk_bf16(o[2], o[3]); w.z = cvt_pk_bf16(o[4], o[5]); w.w = cvt_pk_bf16(o[6], o[7]);
                *(u32x4*)rowp = w; }
    }
};

template <class Epi, class Sched>
__device__ __forceinline__ void gemm_phase(PG8_LAS unsigned char* lds, const Gemm g, const Sched& S, const Epi& E) {
    constexpr bool GA = Sched::GATHER;
    const int tid = opaque_tid(), wid = __builtin_amdgcn_readfirstlane(tid >> 6), lane = tid & 63, wr = wid >> 2, wc = wid & 3, fr = lane & 15, fq = lane >> 4;
    const int K = g.K, nt = K / BK;
    const size_t kstep = (size_t)(BK * 2);
    const size_t hstep = (size_t)HALF * K * 2;
    const size_t tstep = 2 * hstep;
    unsigned voffB[2]; int RA[2], CA[2];
#pragma unroll
    for (int i = 0; i < 2; ++i) { int R, C; stage_rc(tid * 16 + i * 8192, R, C); const int Rb = Epi::PERM ? ((R & ~31) + perm32(R & 31)) : R;
        RA[i] = R; CA[i] = C; voffB[i] = (unsigned)(Rb * K + C) * 2u; }
    const unsigned ldsw = (unsigned)wid * 1024u;
    const int aoff = lds_byte(wr * 64 + fr, fq * 8), boff = lds_byte(wc * 32 + fr, fq * 8);
#define PG8_SA(b, h) (((b) * 2 + (h)) * HTB)
#define PG8_SB(b, h) ((4 + (b) * 2 + (h)) * HTB)
#define PG8_STAGE2(bufoff, gbase, o0, o1) do { \
        __builtin_amdgcn_global_load_lds((const unsigned*)((const char*)(gbase) + (o0)), (PG8_LAS unsigned*)(lds + (bufoff) + ldsw), 16, 0, 0); \
        __builtin_amdgcn_global_load_lds((const unsigned*)((const char*)(gbase) + (o1)), (PG8_LAS unsigned*)(lds + (bufoff) + ldsw + 8192), 16, 0, 0); } while (0)
#define PG8_STAGEB(bufoff, gbase) PG8_STAGE2(bufoff, gbase, voffB[0], voffB[1])
#define PG8_LDA(dst, b, h) do { _Pragma("unroll") for (int m = 0; m < 4; ++m) _Pragma("unroll") for (int k = 0; k < 2; ++k) dst[m][k] = *(const PG8_LAS bf16x8*)(lds + PG8_SA(b, h) + aoff + m * 2048 + k * 1024); } while (0)
#define PG8_LDB(dst, b, h) do { _Pragma("unroll") for (int n = 0; n < 2; ++n) _Pragma("unroll") for (int k = 0; k < 2; ++k) dst[n][k] = *(const PG8_LAS bf16x8*)(lds + PG8_SB(b, h) + boff + n * 2048 + k * 1024); } while (0)
#define PG8_MMA(ai, bj, At, Bt) do { __builtin_amdgcn_s_setprio(1); _Pragma("unroll") for (int m = 0; m < 4; ++m) _Pragma("unroll") for (int n = 0; n < 2; ++n) _Pragma("unroll") for (int k = 0; k < 2; ++k) \
        acc[ai][bj][m][n] = __builtin_amdgcn_mfma_f32_16x16x32_bf16(Bt[n][k], At[m][k], acc[ai][bj][m][n], 0, 0, 0); __builtin_amdgcn_s_setprio(0); } while (0)
#define PG8_WAIT_V(n) asm volatile("s_waitcnt vmcnt(" #n ")" ::: "memory")
#define PG8_WAIT_L(n) asm volatile("s_waitcnt lgkmcnt(" #n ")" ::: "memory")
#define PG8_BAR __builtin_amdgcn_s_barrier()
#define PG8_SCHED __builtin_amdgcn_sched_barrier(0)
    Unit cur, nxt; int ui = 0;
    if (!S.next(0, cur)) return;
    f32x4 acc[2][2][4][2];
#pragma unroll
    for (int a = 0; a < 2; ++a)
#pragma unroll
        for (int b = 0; b < 2; ++b)
#pragma unroll
            for (int m = 0; m < 4; ++m)
#pragma unroll
                for (int n = 0; n < 2; ++n) acc[a][b][m][n] = (f32x4){0.f, 0.f, 0.f, 0.f};
    bf16x8 At[4][2], B0[2][2], B1[2][2];
    unsigned vA[2][2];
    if constexpr (GA) {
        if (tid < BM) S.tokl[tid] = S.src_row(cur, tid);
        asm volatile("s_waitcnt vmcnt(0) lgkmcnt(0)" ::: "memory"); __builtin_amdgcn_s_barrier(); asm volatile("" ::: "memory");
#pragma unroll
        for (int h = 0; h < 2; ++h)
#pragma unroll
            for (int i = 0; i < 2; ++i) vA[h][i] = (unsigned)(S.tokl[h * HALF + RA[i]] * K + CA[i]) * 2u;
    } else {
#pragma unroll
        for (int h = 0; h < 2; ++h)
#pragma unroll
            for (int i = 0; i < 2; ++i) vA[h][i] = (unsigned)(RA[i] * K + CA[i]) * 2u;
    }
    const size_t ah = GA ? (size_t)0 : hstep;
    const char* cA = GA ? (const char*)g.A : (const char*)g.A + (size_t)cur.pm * tstep;
    const char* cB = (const char*)(g.Bt + (size_t)cur.bsel * g.bstride) + (size_t)cur.pn * tstep;
    PG8_STAGEB(PG8_SB(0, 0), cB); PG8_STAGEB(PG8_SB(0, 1), cB + hstep); PG8_STAGE2(PG8_SA(0, 0), cA, vA[0][0], vA[0][1]); PG8_STAGE2(PG8_SA(0, 1), cA + ah, vA[1][0], vA[1][1]);
    if (wr == 1) PG8_BAR;
    PG8_WAIT_V(2); PG8_BAR;
    PG8_STAGEB(PG8_SB(1, 0), cB + kstep); PG8_STAGE2(PG8_SA(1, 0), cA + kstep, vA[0][0], vA[0][1]); PG8_STAGEB(PG8_SB(1, 1), cB + hstep + kstep);
    PG8_WAIT_V(6); PG8_BAR;
    for (;;) {
        const bool has_next = S.next(ui + 1, nxt);
        if constexpr (GA) { if (has_next && tid < BM) S.tokl[tid] = S.src_row(nxt, tid); }
        const char* nA = GA ? cA : (has_next ? (const char*)g.A + (size_t)nxt.pm * tstep : cA);
        const char* nB = has_next ? (const char*)(g.Bt + (size_t)nxt.bsel * g.bstride) + (size_t)nxt.pn * tstep : cB;
        for (int t = 0; t < nt; t += 2) {
            const bool last = (t == nt - 2);
            const char* a1 = cA + (size_t)(t + 1) * kstep;
            const char* a2 = last ? nA : cA + (size_t)(t + 2) * kstep; const char* b2 = last ? nB : cB + (size_t)(t + 2) * kstep;
            const char* a3 = a2 + kstep; const char* b3 = b2 + kstep;
            PG8_LDB(B0, 0, 0); PG8_LDB(B1, 0, 1); PG8_SCHED; PG8_LDA(At, 0, 0); PG8_STAGE2(PG8_SA(1, 1), a1 + ah, vA[1][0], vA[1][1]);
            if constexpr (GA) { if (last) {
#pragma unroll
                for (int h = 0; h < 2; ++h)
#pragma unroll
                    for (int i = 0; i < 2; ++i) vA[h][i] = (unsigned)(S.tokl[h * HALF + RA[i]] * K + CA[i]) * 2u; } }
            PG8_WAIT_V(8); PG8_WAIT_L(0); PG8_BAR; PG8_MMA(0, 0, At, B0); PG8_MMA(0, 1, At, B1); PG8_BAR; PG8_SCHED;
            PG8_LDA(At, 0, 1); PG8_STAGEB(PG8_SB(0, 0), b2); PG8_STAGEB(PG8_SB(0, 1), b2 + hstep); PG8_STAGE2(PG8_SA(0, 0), a2, vA[0][0], vA[0][1]);
            PG8_WAIT_V(8); PG8_WAIT_L(0); PG8_BAR; PG8_MMA(1, 0, At, B0); PG8_MMA(1, 1, At, B1); PG8_BAR; PG8_SCHED;
            PG8_LDB(B0, 1, 0); PG8_LDB(B1, 1, 1); PG8_SCHED; PG8_LDA(At, 1, 0); PG8_STAGE2(PG8_SA(0, 1), a2 + ah, vA[1][0], vA[1][1]);
            PG8_WAIT_V(8); PG8_WAIT_L(0); PG8_BAR; PG8_MMA(0, 0, At, B0); PG8_MMA(0, 1, At, B1); PG8_BAR; PG8_SCHED;
            PG8_LDA(At, 1, 1); PG8_STAGEB(PG8_SB(1, 0), b3); PG8_STAGEB(PG8_SB(1, 1), b3 + hstep); PG8_STAGE2(PG8_SA(1, 0), a3, vA[0][0], vA[0][1]);
            PG8_WAIT_V(8); PG8_WAIT_L(0); PG8_BAR; PG8_MMA(1, 0, At, B0); PG8_MMA(1, 1, At, B1); PG8_BAR; PG8_SCHED;
        }
        if (wr == 0) PG8_BAR;
        E(acc, cur, wr, wc, fr, fq);
        if (!has_next) break;
#pragma unroll
        for (int a = 0; a < 2; ++a)
#pragma unroll
            for (int b = 0; b < 2; ++b)
#pragma unroll
                for (int m = 0; m < 4; ++m)
#pragma unroll
                    for (int n = 0; n < 2; ++n) acc[a][b][m][n] = (f32x4){0.f, 0.f, 0.f, 0.f};
        cur = nxt; cA = nA; cB = nB; ++ui;
        if (wr == 1) PG8_BAR;
    }
    PG8_WAIT_V(0);
    PG8_BAR;
#undef PG8_SA
#undef PG8_SB
#undef PG8_STAGE2
#undef PG8_STAGEB
#undef PG8_LDA
#undef PG8_LDB
#undef PG8_MMA
#undef PG8_WAIT_V
#undef PG8_WAIT_L
#undef PG8_BAR
#undef PG8_SCHED
}
}

namespace att {
typedef short bf16x8 __attribute__((ext_vector_type(8)));
typedef short s16x4 __attribute__((ext_vector_type(4)));
typedef float f32x16 __attribute__((ext_vector_type(16)));
constexpr int KVBLK = 64, SHM_K = 16384, SHM_V = 16384;
constexpr float LOG2E = 1.4426950408889634f;
#define KSWZ(row, colB) ((row) * 256 + ((colB) ^ (((row) & 7) << 4)))
#define SBAR() __builtin_amdgcn_sched_barrier(0)
DEV int v_st(int k, int c) { const int kk = (k & ~0xC) | ((k & 4) << 1) | ((k & 8) >> 1); return ((kk >> 3) * 4 + (c >> 5)) * 512 + ((kk & 7) * 32 + (c & 31)) * 2; }
DEV int v_rd_base(int lane) { return ((lane & 3) << 3) | (((lane >> 2) & 3) << 6) | (((lane >> 4) & 1) << 5) | (((lane >> 5) & 1) << 8); }
constexpr int v_rd_off(int d0, int ks, int half) { return d0 * 512 + ks * 4096 + half * 2048; }
DEV int crow(int r, int hi) { return (r & 3) + 8 * (r >> 2) + 4 * hi; }
DEV unsigned cvtpk(float lo, float hi) { unsigned r; asm volatile("v_cvt_pk_bf16_f32 %0, %1, %2" : "=v"(r) : "v"(lo), "v"(hi)); return r; }
template <int ND>
DEV void qkt(f32x16& p0, f32x16& p1, const char* kbase, int r32, int hi, const bf16x8* qr) {
    p0 = f32x16{}; p1 = f32x16{};
    const char* kb[4];
#pragma unroll
    for (int dd = 0; dd < 4; ++dd) kb[dd] = kbase + KSWZ(r32, (dd * 16 + hi * 8) * 2);
#pragma unroll
    for (int d0 = 0; d0 < ND; ++d0) { const char* a = kb[d0 & 3] + (d0 >> 2) * 128;
        bf16x8 b0 = *reinterpret_cast<const bf16x8*>(a);
        bf16x8 b1 = *reinterpret_cast<const bf16x8*>(a + 32 * 256);
        p0 = __builtin_amdgcn_mfma_f32_32x32x16_bf16(b0, qr[d0], p0, 0, 0, 0);
        p1 = __builtin_amdgcn_mfma_f32_32x32x16_bf16(b1, qr[d0], p1, 0, 0, 0); }
}
DEV void qkt_half_acc(f32x16& p0, const char* kbase, int r32, int hi, const bf16x8* qr) {
    const char* kb[4];
#pragma unroll
    for (int dd = 0; dd < 4; ++dd) kb[dd] = kbase + KSWZ(r32, (dd * 16 + hi * 8) * 2);
#pragma unroll
    for (int d0 = 0; d0 < 8; ++d0) { const char* a = kb[d0 & 3] + (d0 >> 2) * 128;
        bf16x8 b0 = *reinterpret_cast<const bf16x8*>(a);
        p0 = __builtin_amdgcn_mfma_f32_32x32x16_bf16(b0, qr[d0], p0, 0, 0, 0); }
}
template <int VB, int ND0 = 4>
DEV void pv_tile(f32x16* o, int vb0, bf16x8 pa0, bf16x8 pa1, bf16x8 pa2, bf16x8 pa3) {
#define TRRD(dst, off) asm volatile("ds_read_b64_tr_b16 %0, %1 offset:%2" : "=&v"(dst) : "v"(vb0), "i"(off) : "memory")
#define PV_D0(d0) do { s16x4 l0, l1, l2, l3, h0, h1, h2, h3; constexpr int b_ = VB * SHM_V + v_rd_off(d0, 0, 0);   \
        TRRD(l0, b_); TRRD(h0, b_ + 2048); TRRD(l1, b_ + 4096); TRRD(h1, b_ + 6144); TRRD(l2, b_ + 8192); TRRD(h2, b_ + 10240); TRRD(l3, b_ + 12288); TRRD(h3, b_ + 14336); \
        asm volatile("s_waitcnt lgkmcnt(0)" ::: "memory"); SBAR();   \
        o[d0] = __builtin_amdgcn_mfma_f32_32x32x16_bf16(pa0, (bf16x8){l0[0], l0[1], l0[2], l0[3], h0[0], h0[1], h0[2], h0[3]}, o[d0], 0, 0, 0);   \
        o[d0] = __builtin_amdgcn_mfma_f32_32x32x16_bf16(pa1, (bf16x8){l1[0], l1[1], l1[2], l1[3], h1[0], h1[1], h1[2], h1[3]}, o[d0], 0, 0, 0);   \
        o[d0] = __builtin_amdgcn_mfma_f32_32x32x16_bf16(pa2, (bf16x8){l2[0], l2[1], l2[2], l2[3], h2[0], h2[1], h2[2], h2[3]}, o[d0], 0, 0, 0);   \
        o[d0] = __builtin_amdgcn_mfma_f32_32x32x16_bf16(pa3, (bf16x8){l3[0], l3[1], l3[2], l3[3], h3[0], h3[1], h3[2], h3[3]}, o[d0], 0, 0, 0); } while (0)
    PV_D0(0); if constexpr (ND0 > 1) PV_D0(1); if constexpr (ND0 > 2) { PV_D0(2); PV_D0(3); }
#undef PV_D0
#undef TRRD
}
DEV void pack_p(const f32x16& p0, const f32x16& p1, bf16x8& pa0, bf16x8& pa1, bf16x8& pa2, bf16x8& pa3) {
#define PK4(P, B_, OUT) do { unsigned a0 = cvtpk(P[B_+0], P[B_+1]), a1 = cvtpk(P[B_+2], P[B_+3]);                          \
        unsigned b0 = cvtpk(P[B_+4], P[B_+5]), b1 = cvtpk(P[B_+6], P[B_+7]);                                             \
        auto r0 = __builtin_amdgcn_permlane32_swap(a0, b0, false, false); auto r1 = __builtin_amdgcn_permlane32_swap(a1, b1, false, false); \
        u32x4 w = {r0[0], r1[0], r0[1], r1[1]}; OUT = *reinterpret_cast<bf16x8*>(&w); } while (0)
    PK4(p0, 0, pa0); PK4(p0, 8, pa1); PK4(p1, 0, pa2); PK4(p1, 8, pa3);
#undef PK4
}
DEV float half_max(float v) { auto rr = __builtin_amdgcn_permlane32_swap(__float_as_uint(v), __float_as_uint(v), false, false); return fmaxf(__uint_as_float(rr[0]), __uint_as_float(rr[1])); }
DEV float half_sum(float v) { auto rr = __builtin_amdgcn_permlane32_swap(__float_as_uint(v), __float_as_uint(v), false, false); return __uint_as_float(rr[0]) + __uint_as_float(rr[1]); }

constexpr int L_V = 0, L_K = 2 * SHM_V, L_WS = L_K + 2 * SHM_K, L_BT = L_WS + 8 * 256, L_QW = L_BT + 512, L_END = L_QW + 512;

DEV void moba_unit(const Params& P, char* lds, int layer, int b, int h, int qb) {
    const int tid = opaque_tid(), wid = __builtin_amdgcn_readfirstlane(tid >> 6), lane = tid & 63, r32 = lane & 31, hi = lane >> 5;
    const bf16* QKV = (const bf16*)(P.ws + WS_BIG);
    char* V_lds = lds + L_V; char* K_lds = lds + L_K;
    float* wsf = (float*)(lds + L_WS) + wid * 64; float* li_l = wsf; float* al_l = wsf + 32;
    float* bt = (float*)(lds + L_BT); const float* qw = (const float*)(lds + L_QW);
    const int sr = tid >> 4, sc = (tid & 15) * 8, vst0 = v_st(sr, sc), vst1 = v_st(32 + sr, sc), kws = KSWZ(sr, sc * 2);
    const int vb0 = (int)(uintptr_t)V_lds + v_rd_base(lane);
    const size_t tok0 = (size_t)b * SEQ;
    if (tid < 128) bt[tid] = ((const float*)(P.ws + WS_BT))[h * 128 + tid];
    if (tid < 256) { const int row = tid >> 4, ch = tid & 15; const float* km = (const float*)(P.ws + WS_KMEAN) + ((((size_t)b * 16 + row) * 8 + h) * 128 + ch * 8);
        const f32x4 a = *(const f32x4*)km, c = *(const f32x4*)(km + 4);
        float x[8] = {a.x, a.y, a.z, a.w, c.x, c.y, c.z, c.w}; unsigned hw[4], lw[4];
#pragma unroll
        for (int i = 0; i < 4; ++i) { const unsigned h0 = f2bf(x[2 * i]), h1 = f2bf(x[2 * i + 1]); hw[i] = h0 | (h1 << 16);
            lw[i] = pk2(x[2 * i] - __uint_as_float(h0 << 16), x[2 * i + 1] - __uint_as_float(h1 << 16)); }
        *(u32x4*)(K_lds + KSWZ(row, ch * 16)) = (u32x4){hw[0], hw[1], hw[2], hw[3]};
        *(u32x4*)(K_lds + SHM_K + KSWZ(row, ch * 16)) = (u32x4){lw[0], lw[1], lw[2], lw[3]}; }
    bf16x8 qr[8];
    { const bf16* qp = QKV + (tok0 + qb * 256 + wid * 32 + r32) * ODN + h * 128 + hi * 8;
      u32x4 raw[8]; float ss = 0.f;
#pragma unroll
      for (int d0 = 0; d0 < 8; ++d0) { raw[d0] = *(const u32x4*)(qp + d0 * 16);
#pragma unroll
          for (int i = 0; i < 4; ++i) { const float lo = bflo(raw[d0][i]), hh = bfhi(raw[d0][i]); ss += lo * lo + hh * hh; } }
      ss = half_sum(ss);
      const float rs = rsqrtf(ss * (1.f / 128.f) + RMS_EPS);
      __syncthreads();
#pragma unroll
      for (int d0 = 0; d0 < 8; ++d0) { const f32x4 w0 = *(const f32x4*)(qw + d0 * 16 + hi * 8), w1 = *(const f32x4*)(qw + d0 * 16 + hi * 8 + 4);
          u32x4 o; o.x = cvtpk(bflo(raw[d0].x) * rs * w0.x, bfhi(raw[d0].x) * rs * w0.y); o.y = cvtpk(bflo(raw[d0].y) * rs * w0.z, bfhi(raw[d0].y) * rs * w0.w);
          o.z = cvtpk(bflo(raw[d0].z) * rs * w1.x, bfhi(raw[d0].z) * rs * w1.y); o.w = cvtpk(bflo(raw[d0].w) * rs * w1.z, bfhi(raw[d0].w) * rs * w1.w);
          qr[d0] = *reinterpret_cast<bf16x8*>(&o); } }
    unsigned selmask = 0u;
    { f32x16 ps = f32x16{};
      qkt_half_acc(ps, K_lds, r32, hi, qr); qkt_half_acc(ps, K_lds + SHM_K, r32, hi, qr);
      float scv[16];
#pragma unroll
      for (int r = 0; r < 8; ++r) { const float mine = ps[r], oth = __shfl_xor(mine, 32); const int jm = (r & 3) + 8 * (r >> 2);
          scv[jm + 4 * 0] = hi ? oth : mine; scv[jm + 4] = hi ? mine : oth; }
#pragma unroll
      for (int j = 0; j < 16; ++j) if (j >= qb) scv[j] = -INFINITY;
#pragma unroll
      for (int n = 0; n < 3; ++n) { float mx = -INFINITY; int ix = -1;
#pragma unroll
          for (int j = 0; j < 16; ++j) if (scv[j] > mx) { mx = scv[j]; ix = j; }
#pragma unroll
          for (int j = 0; j < 16; ++j) if (j == ix) scv[j] = -INFINITY;
          if (ix >= 0) selmask |= 1u << ix; } }
    __syncthreads();
    const int NT = 4 * (qb + 1);
    const int qrow = wid * 32 + r32;
    const bf16* Kg = QKV + tok0 * ODN + 1024 + h * 128 + sc; const bf16* Vg = Kg + 1024;
    bf16x8 st_k0, st_k1, st_v0, st_v1;
#define SLOAD(t) do { const size_t k0_ = (size_t)(t) * 64; st_k0 = *(const bf16x8*)(Kg + (k0_ + sr) * ODN); st_k1 = *(const bf16x8*)(Kg + (k0_ + 32 + sr) * ODN); \
                      st_v0 = *(const bf16x8*)(Vg + (k0_ + sr) * ODN); st_v1 = *(const bf16x8*)(Vg + (k0_ + 32 + sr) * ODN); } while (0)
#define SWRITE(bf) do { *(bf16x8*)(K_lds + (bf) * SHM_K + kws) = st_k0; *(bf16x8*)(K_lds + (bf) * SHM_K + kws + 32 * 256) = st_k1; \
                        *(bf16x8*)(V_lds + (bf) * SHM_V + vst0) = st_v0; *(bf16x8*)(V_lds + (bf) * SHM_V + vst1) = st_v1; } while (0)
    float m_reg = -1e30f, l_reg = 0.f; f32x16 o[4] = {};
    const float cfar = bt[127];
    SLOAD(0); SWRITE(0); __syncthreads();
#define TILE_STEP(t, BUF) do { \
        if ((t) + 1 < NT) SLOAD((t) + 1); \
        const int jb_ = (t) >> 2, tt_ = (t) & 3; const bool own_ = (jb_ == qb); \
        const bool need_ = own_ ? (tt_ * 64 <= wid * 32 + 31) : (__ballot((selmask >> jb_) & 1u) != 0ull);     \
        if (need_) { \
            f32x16 p0, p1; qkt<8>(p0, p1, K_lds + (BUF) * SHM_K, r32, hi, qr); \
            const int dq_ = (qb - jb_) * 256 + qrow - tt_ * 64 - 4 * hi;                   \
            const bool far_ = ((qb - jb_) * 256 + wid * 32 - tt_ * 64 - 63) >= 127;        \
            if (far_) { _Pragma("unroll") for (int r = 0; r < 16; ++r) { p0[r] = fmaf(p0[r], 0.08838834764831845f, cfar); p1[r] = fmaf(p1[r], 0.08838834764831845f, cfar); } } \
            else { _Pragma("unroll") for (int r = 0; r < 16; ++r) { const int c_ = (r & 3) + 8 * (r >> 2); const int d0_ = dq_ - c_, d1_ = d0_ - 32; \
                       const float b0_ = bt[d0_ < 0 ? 0 : (d0_ > 127 ? 127 : d0_)], b1_ = bt[d1_ < 0 ? 0 : (d1_ > 127 ? 127 : d1_)]; \
                       p0[r] = d0_ < 0 ? -INFINITY : fmaf(p0[r], 0.08838834764831845f, b0_); p1[r] = d1_ < 0 ? -INFINITY : fmaf(p1[r], 0.08838834764831845f, b1_); } } \
            if (!own_ && !((selmask >> jb_) & 1u)) { _Pragma("unroll") for (int r = 0; r < 16; ++r) { p0[r] = -INFINITY; p1[r] = -INFINITY; } } \
            float pmax_ = p0[0]; _Pragma("unroll") for (int r = 1; r < 16; ++r) pmax_ = fmaxf(pmax_, p0[r]); _Pragma("unroll") for (int r = 0; r < 16; ++r) pmax_ = fmaxf(pmax_, p1[r]); \
            pmax_ = half_max(pmax_); \
            const float mn_ = fmaxf(m_reg, pmax_); const float alpha_ = __builtin_amdgcn_exp2f((m_reg - mn_) * LOG2E); m_reg = mn_; \
            const float mnl_ = -mn_ * LOG2E; float psum_ = 0.f; \
            _Pragma("unroll") for (int r = 0; r < 16; ++r) { p0[r] = __builtin_amdgcn_exp2f(fmaf(p0[r], LOG2E, mnl_)); p1[r] = __builtin_amdgcn_exp2f(fmaf(p1[r], LOG2E, mnl_)); psum_ += p0[r] + p1[r]; } \
            psum_ = half_sum(psum_); l_reg = l_reg * alpha_ + psum_; \
            bf16x8 pa0, pa1, pa2, pa3; pack_p(p0, p1, pa0, pa1, pa2, pa3); \
            if (__any(alpha_ < 1.f)) { if (hi == 0) al_l[r32] = alpha_; asm volatile("s_waitcnt lgkmcnt(0)" ::: "memory"); \
                _Pragma("unroll") for (int d_ = 0; d_ < 4; ++d_) _Pragma("unroll") for (int r = 0; r < 16; ++r) o[d_][r] *= al_l[crow(r, hi)]; } \
            pv_tile<BUF>(o, vb0, pa0, pa1, pa2, pa3); \
        } \
        if ((t) + 1 < NT) { SWRITE((BUF) ^ 1); } \
        __syncthreads(); } while (0)
    for (int t = 0; t < NT; t += 2) { TILE_STEP(t, 0); TILE_STEP(t + 1, 1); }
#undef TILE_STEP
#undef SLOAD
#undef SWRITE
    if (hi == 0) li_l[r32] = l_reg; asm volatile("s_waitcnt lgkmcnt(0)" ::: "memory");
    bf16* Ow = (bf16*)(P.ws + WS_MIX) + (tok0 + qb * 256 + wid * 32) * DM + h * 128;
#pragma unroll
    for (int r = 0; r < 16; ++r) { const int orow = crow(r, hi); const float rl = __builtin_amdgcn_rcpf(li_l[orow]);
#pragma unroll
        for (int d0 = 0; d0 < 4; ++d0) { const float v = o[d0][r] * rl; const float vn = __shfl_xor(v, 1);
            if ((r32 & 1) == 0) *(unsigned*)(Ow + (size_t)orow * DM + d0 * 32 + r32) = cvtpk(v, vn); } }
    __syncthreads();
}
DEV void phase_moba(const Params& P, unsigned char* lds, int vb, int nvb, int layer) {
    { const int tid = opaque_tid(); if (tid < 128) ((float*)(lds + L_QW))[tid] = P.in[I_CQN][(layer >> 1) * 128 + tid]; }
    __syncthreads();
    for (int it = vb; it < NBATCH * 8 * 8; it += nvb) {
        const int pr = it & 7, h = (it >> 3) & 7, b = it >> 6;
        moba_unit(P, (char*)lds, layer, b, h, pr);
        moba_unit(P, (char*)lds, layer, b, h, 15 - pr);
    }
}

constexpr int S_V = 0, S_K = 65536, S_WS = 131072, S_BT = S_WS + 2048, S_QW = S_BT + 2048, S_KW = S_QW + 256;
DEV void swa_unit(const Params& P, char* lds, int layer, int b, int kvh, int n) {
    const int tid = opaque_tid(), wid = __builtin_amdgcn_readfirstlane(tid >> 6), lane = tid & 63, r32 = lane & 31, hi = lane >> 5;
    const int g = wid >> 1, h = kvh * 4 + g, jl = layer >> 1;
    const bf16* QKV = (const bf16*)(P.ws + WS_BIG);
    char* V_lds = lds + S_V; char* K_lds = lds + S_K;
    float* wsf = (float*)(lds + S_WS) + wid * 64; float* li_l = wsf; float* al_l = wsf + 32;
    const float* bt = (const float*)(lds + S_BT) + g * 128; const float* qw = (const float*)(lds + S_QW); const float* kw = (const float*)(lds + S_KW);
    ((float*)(lds + S_BT))[tid] = ((const float*)(P.ws + WS_BT))[(kvh * 4 + (tid >> 7)) * 128 + (tid & 127)];
#pragma unroll
    for (int i = 0; i < 4; ++i) { const int idx = tid + 512 * i, key = idx >> 3, ch = idx & 7, s = (n - 1) * 128 + key;
        u32x4 kr = (u32x4){0u, 0u, 0u, 0u}, vr = kr;
        if (s >= 0) { const bf16* rp = QKV + ((size_t)b * SEQ + s) * EVN; kr = *(const u32x4*)(rp + 512 + kvh * 64 + ch * 8); vr = *(const u32x4*)(rp + 640 + kvh * 64 + ch * 8); }
        float kf[8] = {bflo(kr.x), bfhi(kr.x), bflo(kr.y), bfhi(kr.y), bflo(kr.z), bfhi(kr.z), bflo(kr.w), bfhi(kr.w)};
        float ss = 0.f;
#pragma unroll
        for (int e = 0; e < 8; ++e) ss += kf[e] * kf[e];
        ss += __shfl_xor(ss, 1); ss += __shfl_xor(ss, 2); ss += __shfl_xor(ss, 4);
        const float rs = rsqrtf(ss * (1.f / 64.f) + RMS_EPS);
        const f32x4 w0 = *(const f32x4*)(kw + ch * 8), w1 = *(const f32x4*)(kw + ch * 8 + 4);
        u32x4 ko; ko.x = cvtpk(kf[0] * rs * w0.x, kf[1] * rs * w0.y); ko.y = cvtpk(kf[2] * rs * w0.z, kf[3] * rs * w0.w); ko.z = cvtpk(kf[4] * rs * w1.x, kf[5] * rs * w1.y); ko.w = cvtpk(kf[6] * rs * w1.z, kf[7] * rs * w1.w);
        *(u32x4*)(K_lds + (key >> 6) * SHM_K + KSWZ(key & 63, ch * 16)) = ko;
        *(u32x4*)(V_lds + (key >> 6) * SHM_V + v_st(key & 63, ch * 8)) = vr; }
    __syncthreads();
    const int vb0 = (int)(uintptr_t)V_lds + v_rd_base(lane);
    const float sink = P.in[I_ASINK][jl * 8 + h];
#pragma unroll 1
    for (int gi = 0; gi < 2; ++gi) {
        const int q0 = (wid & 1) * 64 + gi * 32; const size_t tok = (size_t)b * SEQ + n * 128 + q0 + r32;
        bf16x8 qr[4];
        { const bf16* qp = QKV + tok * EVN + h * 64 + hi * 8; u32x4 raw[4]; float ss = 0.f;
#pragma unroll
          for (int d0 = 0; d0 < 4; ++d0) { raw[d0] = *(const u32x4*)(qp + d0 * 16);
#pragma unroll
              for (int i = 0; i < 4; ++i) { const float lo = bflo(raw[d0][i]), hh = bfhi(raw[d0][i]); ss += lo * lo + hh * hh; } }
          ss = half_sum(ss); const float rs = rsqrtf(ss * (1.f / 64.f) + RMS_EPS);
#pragma unroll
          for (int d0 = 0; d0 < 4; ++d0) { const f32x4 w0 = *(const f32x4*)(qw + d0 * 16 + hi * 8), w1 = *(const f32x4*)(qw + d0 * 16 + hi * 8 + 4);
              u32x4 o; o.x = cvtpk(bflo(raw[d0].x) * rs * w0.x, bfhi(raw[d0].x) * rs * w0.y); o.y = cvtpk(bflo(raw[d0].y) * rs * w0.z, bfhi(raw[d0].y) * rs * w0.w);
              o.z = cvtpk(bflo(raw[d0].z) * rs * w1.x, bfhi(raw[d0].z) * rs * w1.y); o.w = cvtpk(bflo(raw[d0].w) * rs * w1.z, bfhi(raw[d0].w) * rs * w1.w);
              qr[d0] = *reinterpret_cast<bf16x8*>(&o); } }
        float m_reg = sink, l_reg = 1.f; f32x16 o2[2] = {};
        const int tile0 = q0 >> 6;
#pragma unroll 1
        for (int tt = 0; tt < 3; ++tt) {
            const int tile = tile0 + tt;
            if (n == 0 && tile < 2) continue;
            f32x16 p0, p1; qkt<4>(p0, p1, K_lds + tile * SHM_K, r32, hi, qr);
            const int dq = 128 + q0 + r32 - tile * 64 - 4 * hi;
#pragma unroll
            for (int r = 0; r < 16; ++r) { const int c = (r & 3) + 8 * (r >> 2); const int d0_ = dq - c, d1_ = d0_ - 32;
                const float b0_ = bt[d0_ & 127], b1_ = bt[d1_ & 127];
                p0[r] = ((unsigned)d0_ < 128u) ? fmaf(p0[r], 0.125f, b0_) : -INFINITY; p1[r] = ((unsigned)d1_ < 128u) ? fmaf(p1[r], 0.125f, b1_) : -INFINITY; }
            float pmax = p0[0];
#pragma unroll
            for (int r = 1; r < 16; ++r) pmax = fmaxf(pmax, p0[r]);
#pragma unroll
            for (int r = 0; r < 16; ++r) pmax = fmaxf(pmax, p1[r]);
            pmax = half_max(pmax);
            const float mn = fmaxf(m_reg, pmax), alpha = __builtin_amdgcn_exp2f((m_reg - mn) * LOG2E); m_reg = mn;
            const float mnl = -mn * LOG2E; float psum = 0.f;
#pragma unroll
            for (int r = 0; r < 16; ++r) { p0[r] = __builtin_amdgcn_exp2f(fmaf(p0[r], LOG2E, mnl)); p1[r] = __builtin_amdgcn_exp2f(fmaf(p1[r], LOG2E, mnl)); psum += p0[r] + p1[r]; }
            psum = half_sum(psum); l_reg = l_reg * alpha + psum;
            bf16x8 pa0, pa1, pa2, pa3; pack_p(p0, p1, pa0, pa1, pa2, pa3);
            if (__any(alpha < 1.f)) { if (hi == 0) al_l[r32] = alpha; asm volatile("s_waitcnt lgkmcnt(0)" ::: "memory");
#pragma unroll
                for (int d_ = 0; d_ < 2; ++d_)
#pragma unroll
                    for (int r = 0; r < 16; ++r) o2[d_][r] *= al_l[crow(r, hi)]; }
            pv_tile<0, 2>(o2, vb0 + tile * SHM_V, pa0, pa1, pa2, pa3);
        }
        if (hi == 0) li_l[r32] = l_reg; asm volatile("s_waitcnt lgkmcnt(0)" ::: "memory");
        bf16* Ow = (bf16*)(P.ws + WS_MIX) + ((size_t)b * SEQ + n * 128 + q0) * DM + h * 64;
#pragma unroll
        for (int r = 0; r < 16; ++r) { const int orow = crow(r, hi); const float rl = __builtin_amdgcn_rcpf(li_l[orow]);
#pragma unroll
            for (int d0 = 0; d0 < 2; ++d0) { const float v = o2[d0][r] * rl; const float vn = __shfl_xor(v, 1);
                if ((r32 & 1) == 0) *(unsigned*)(Ow + (size_t)orow * DM + d0 * 32 + r32) = cvtpk(v, vn); } }
        asm volatile("s_waitcnt lgkmcnt(0)" ::: "memory");
    }
    __syncthreads();
}
DEV void phase_swa(const Params& P, unsigned char* lds, int vb, int nvb, int layer) {
    { const int tid = opaque_tid(); if (tid < 64) { ((float*)(lds + S_QW))[tid] = P.in[I_AQN][(layer >> 1) * 64 + tid]; ((float*)(lds + S_KW))[tid] = P.in[I_AKN][(layer >> 1) * 64 + tid]; } }
    __syncthreads();
    for (int it = vb; it < NBATCH * 2 * 32; it += nvb) swa_unit(P, (char*)lds, layer, it >> 6, (it >> 5) & 1, it & 31);
}

constexpr int G_G = 0, G_K = 16384, G_V = 32768, G_S = 49152, G_QD = 65536, G_KT = 73728, G_SEG = 81920, G_WS = 83968;
DEV void gla_gates(const Params& P, char* lds, int layer, int b, int h, int n, int tid) {
    const int seg = tid >> 6, dk = tid & 63, jl = layer >> 1;
    float* G = (float*)(lds + G_G); float* segs = (float*)(lds + G_SEG);
    float gu[16];
#pragma unroll
    for (int r = 0; r < 16; ++r) gu[r] = P.in[I_BGU][((size_t)jl * 16 + r) * 256 + h * 64 + dk];
    const float bias = P.in[I_BGB][jl * 256 + h * 64 + dk];
    const float* AB = (const float*)(P.ws + WS_AB) + ((size_t)b * SEQ + n * 64 + seg * 8) * 16;
    float vals[8], run = 0.f;
#pragma unroll
    for (int i = 0; i < 8; ++i) { const f32x4 a0 = *(const f32x4*)(AB + i * 16), a1 = *(const f32x4*)(AB + i * 16 + 4), a2 = *(const f32x4*)(AB + i * 16 + 8), a3 = *(const f32x4*)(AB + i * 16 + 12);
        float z = bias;
        z += a0.x * gu[0] + a0.y * gu[1] + a0.z * gu[2] + a0.w * gu[3]; z += a1.x * gu[4] + a1.y * gu[5] + a1.z * gu[6] + a1.w * gu[7];
        z += a2.x * gu[8] + a2.y * gu[9] + a2.z * gu[10] + a2.w * gu[11]; z += a3.x * gu[12] + a3.y * gu[13] + a3.z * gu[14] + a3.w * gu[15];
        run += log_sigmoid_f(z) * (1.f / 16.f); vals[i] = run; }
    segs[seg * 64 + dk] = run;
    __syncthreads();
    float pre = 0.f;
#pragma unroll
    for (int s = 0; s < 8; ++s) pre += (s < seg) ? segs[s * 64 + dk] : 0.f;
#pragma unroll
    for (int i = 0; i < 8; ++i) G[(seg * 8 + i) * 64 + dk] = vals[i] + pre;
    __syncthreads();
}
DEV void gla_stage_v(const bf16* src, size_t pitch, char* dst, int tid) {
#pragma unroll
    for (int i = 0; i < 2; ++i) { const int idx = tid + 512 * i, row = idx >> 4, ch = idx & 15; *(u32x4*)(dst + v_st(row, ch * 8)) = *(const u32x4*)(src + (size_t)row * pitch + ch * 8); }
}
DEV void gla_local_unit(const Params& P, char* lds, int layer, int b, int h, int n) {
    const int tid = opaque_tid(), wid = __builtin_amdgcn_readfirstlane(tid >> 6), lane = tid & 63, r32 = lane & 31, hi = lane >> 5;
    const bf16* QKV = (const bf16*)(P.ws + WS_BIG); const float* G = (const float*)(lds + G_G);
    const int chd = (b * 4 + h) * 64 + n; const size_t tok0 = (size_t)b * SEQ + n * 64;
    gla_gates(P, lds, layer, b, h, n, tid);
    { const int j = tid >> 3, c8 = (tid & 7) * 8; const u32x4 kr = *(const u32x4*)(QKV + (tok0 + j) * EVN + 1024 + h * 64 + c8);
      const float kf[8] = {bflo(kr.x), bfhi(kr.x), bflo(kr.y), bfhi(kr.y), bflo(kr.z), bfhi(kr.z), bflo(kr.w), bfhi(kr.w)};
      bf16* kdT = (bf16*)(lds + G_KT);
#pragma unroll
      for (int e = 0; e < 8; ++e) { const float bl = G[63 * 64 + c8 + e], bj = G[j * 64 + c8 + e]; kdT[(c8 + e) * 64 + j] = (bf16)f2bf(kf[e] * __expf(bl - bj));
          if (j == 63) ((float*)(P.ws + WS_DEC))[(size_t)chd * 64 + c8 + e] = __expf(bl); } }
    gla_stage_v(QKV + tok0 * EVN + 1280 + h * 128, EVN, lds + G_V, tid);
    __syncthreads();
    const int rh = wid >> 2, dq = wid & 3;
    bf16x8 pa[4];
#pragma unroll
    for (int ks = 0; ks < 4; ++ks) pa[ks] = *(const bf16x8*)(lds + G_KT + ((32 * rh + r32) * 64 + ks * 16 + hi * 8) * 2);
    f32x16 o1[1] = {};
    pv_tile<0, 1>(o1, (int)(uintptr_t)(lds + G_V) + v_rd_base(lane) + dq * 512, pa[0], pa[1], pa[2], pa[3]);
    float* UPD = (float*)(P.ws + WS_UPD) + (size_t)chd * 64 * 128;
#pragma unroll
    for (int r = 0; r < 16; ++r) UPD[(32 * rh + crow(r, hi)) * 128 + dq * 32 + r32] = o1[0][r];
    __syncthreads();
}
DEV void phase_gla_scan(const Params& P, int vb, int nvb) {
    const int tid = opaque_tid();
    const float* UPD = (const float*)(P.ws + WS_UPD); const float* DEC = (const float*)(P.ws + WS_DEC); bf16* SIN = (bf16*)(P.ws + WS_SIN);
    for (int e = vb * 512 + tid; e < 32 * 64 * 64; e += nvb * 512) {
        const int dvp = e & 63, dk = (e >> 6) & 63, bh = e >> 12;
        float s0 = 0.f, s1 = 0.f;
#pragma unroll 8
        for (int n = 0; n < 64; ++n) { const size_t ro = ((size_t)(bh * 64 + n) * 64 + dk);
            const f32x2 u = *(const f32x2*)(UPD + ro * 128 + 2 * dvp); const float d = DEC[ro];
            *(unsigned*)(SIN + ro * 128 + 2 * dvp) = pk2(s0, s1);
            s0 = s0 * d + u.x; s1 = s1 * d + u.y; }
    }
}
DEV void gla_final_unit(const Params& P, char* lds, int layer, int b, int h, int n) {
    const int tid = opaque_tid(), wid = __builtin_amdgcn_readfirstlane(tid >> 6), lane = tid & 63, r32 = lane & 31, hi = lane >> 5;
    const bf16* QKV = (const bf16*)(P.ws + WS_BIG); const float* G = (const float*)(lds + G_G);
    const int chd = (b * 4 + h) * 64 + n, jl = layer >> 1; const size_t tok0 = (size_t)b * SEQ + n * 64;
    gla_gates(P, lds, layer, b, h, n, tid);
    { const int j = tid >> 3, c8 = (tid & 7) * 8; const bf16* rp = QKV + (tok0 + j) * EVN + h * 64 + c8;
      const u32x4 qv = *(const u32x4*)(rp + 768), kr = *(const u32x4*)(rp + 1024);
      const float qf_[8] = {bflo(qv.x), bfhi(qv.x), bflo(qv.y), bfhi(qv.y), bflo(qv.z), bfhi(qv.z), bflo(qv.w), bfhi(qv.w)};
      const float kf[8] = {bflo(kr.x), bfhi(kr.x), bflo(kr.y), bfhi(kr.y), bflo(kr.z), bfhi(kr.z), bflo(kr.w), bfhi(kr.w)};
      float qd_[8], ki_[8];
#pragma unroll
      for (int e = 0; e < 8; ++e) { const float bj = G[j * 64 + c8 + e]; qd_[e] = qf_[e] * 0.125f * __expf(bj); ki_[e] = kf[e] * __expf(-bj); }
      *(u32x4*)(lds + G_QD + (j * 64 + c8) * 2) = (u32x4){cvtpk(qd_[0], qd_[1]), cvtpk(qd_[2], qd_[3]), cvtpk(qd_[4], qd_[5]), cvtpk(qd_[6], qd_[7])};
      *(u32x4*)(lds + G_K + KSWZ(j, c8 * 2)) = (u32x4){cvtpk(ki_[0], ki_[1]), cvtpk(ki_[2], ki_[3]), cvtpk(ki_[4], ki_[5]), cvtpk(ki_[6], ki_[7])}; }
    gla_stage_v(QKV + tok0 * EVN + 1280 + h * 128, EVN, lds + G_V, tid);
    gla_stage_v((const bf16*)(P.ws + WS_SIN) + (size_t)chd * 64 * 128, 128, lds + G_S, tid);
    __syncthreads();
    const int rh = wid >> 2, dq = wid & 3, irow = 32 * rh + r32;
    bf16x8 qf[4];
#pragma unroll
    for (int d0 = 0; d0 < 4; ++d0) qf[d0] = *(const bf16x8*)(lds + G_QD + (irow * 64 + d0 * 16 + hi * 8) * 2);
    f32x16 p0, p1; qkt<4>(p0, p1, lds + G_K, r32, hi, qf);
#pragma unroll
    for (int r = 0; r < 16; ++r) { const int jj = crow(r, hi); p0[r] = (irow >= jj) ? p0[r] : 0.f; p1[r] = (irow >= jj + 32) ? p1[r] : 0.f; }
    bf16x8 pa0, pa1, pa2, pa3; pack_p(p0, p1, pa0, pa1, pa2, pa3);
    f32x16 o1[1] = {};
    pv_tile<0, 1>(o1, (int)(uintptr_t)(lds + G_V) + v_rd_base(lane) + dq * 512, pa0, pa1, pa2, pa3);
    pv_tile<0, 1>(o1, (int)(uintptr_t)(lds + G_S) + v_rd_base(lane) + dq * 512, qf[0], qf[1], qf[2], qf[3]);
    __syncthreads();
    float* obuf = (float*)lds;
#pragma unroll
    for (int r = 0; r < 16; ++r) obuf[(32 * rh + crow(r, hi)) * 128 + dq * 32 + r32] = o1[0][r];
    __syncthreads();
    { const int row = tid >> 3, c16 = (tid & 7) * 16; float ov[16]; float ss = 0.f;
#pragma unroll
      for (int q = 0; q < 4; ++q) { const f32x4 t = *(const f32x4*)(obuf + row * 128 + c16 + 4 * q); ov[4 * q] = t.x; ov[4 * q + 1] = t.y; ov[4 * q + 2] = t.z; ov[4 * q + 3] = t.w; ss += (t.x * t.x + t.y * t.y) + (t.z * t.z + t.w * t.w); }
      ss += __shfl_xor(ss, 1); ss += __shfl_xor(ss, 2); ss += __shfl_xor(ss, 4);
      const float rs = rsqrtf(ss * (1.f / 128.f) + RMS_EPS);
      const bf16* rb = QKV + (tok0 + row) * EVN + 1792 + h * 128 + c16; const float* on = P.in[I_BON] + jl * 128 + c16;
      bf16* op = (bf16*)(P.ws + WS_MIX) + (tok0 + row) * DM + 512 + h * 128 + c16;
#pragma unroll
      for (int hf = 0; hf < 2; ++hf) { const u32x4 gv = *(const u32x4*)(rb + 8 * hf); const f32x4 n0 = *(const f32x4*)(on + 8 * hf), n1 = *(const f32x4*)(on + 8 * hf + 4);
          const float* o8 = ov + 8 * hf;
          u32x4 w; w.x = cvtpk(o8[0] * rs * n0.x * silu_f(bflo(gv.x)), o8[1] * rs * n0.y * silu_f(bfhi(gv.x))); w.y = cvtpk(o8[2] * rs * n0.z * silu_f(bflo(gv.y)), o8[3] * rs * n0.w * silu_f(bfhi(gv.y)));
          w.z = cvtpk(o8[4] * rs * n1.x * silu_f(bflo(gv.z)), o8[5] * rs * n1.y * silu_f(bfhi(gv.z))); w.w = cvtpk(o8[6] * rs * n1.z * silu_f(bflo(gv.w)), o8[7] * rs * n1.w * silu_f(bfhi(gv.w)));
          *(u32x4*)(op + 8 * hf) = w; } }
    __syncthreads();
}
DEV void phase_gla_local(const Params& P, unsigned char* lds, int vb, int nvb, int layer) { for (int it = vb; it < 2048; it += nvb) gla_local_unit(P, (char*)lds, layer, it >> 8, (it >> 6) & 3, it & 63); }
DEV void phase_gla_final(const Params& P, unsigned char* lds, int vb, int nvb, int layer) { for (int it = vb; it < 2048; it += nvb) gla_final_unit(P, (char*)lds, layer, it >> 8, (it >> 6) & 3, it & 63); }
#undef KSWZ
#undef SBAR
}

template <int EPI  >
__global__ void __launch_bounds__(256) k_gemm_naive(const bf16* A, int lda, const float* W, int ldw, int K, int N, bf16* Ob, int ldc, const float* xin, float* xout, const float* gate) {
    const int col = (blockIdx.x * 64 + threadIdx.x) * 4, r0 = blockIdx.y * 16 + threadIdx.y * 4;
    if (col >= N) return;
    f32x4 acc[4];
#pragma unroll
    for (int i = 0; i < 4; ++i) acc[i] = (f32x4){0.f, 0.f, 0.f, 0.f};
    const bf16* a0 = A + (size_t)r0 * lda;
    for (int k = 0; k < K; ++k) {
        const f32x4 w = *(const f32x4*)(W + (size_t)k * ldw + col);
#pragma unroll
        for (int i = 0; i < 4; ++i) acc[i] += w * bf2f(a0[(size_t)i * lda + k]);
    }
#pragma unroll
    for (int i = 0; i < 4; ++i) {
        const int r = r0 + i;
        if (EPI == 0) { u32x2 o; o.x = pk2(acc[i].x, acc[i].y); o.y = pk2(acc[i].z, acc[i].w); *(u32x2*)(Ob + (size_t)r * ldc + col) = o; }
        else { const f32x4 g = *(const f32x4*)(gate + (size_t)(r >> 12) * (6 * DM) + col); const f32x4 xi = *(const f32x4*)(xin + (size_t)r * DM + col);
            *(f32x4*)(xout + (size_t)r * DM + col) = xi + g * acc[i]; }
    }
}
__global__ void __launch_bounds__(256) k_moe_up_naive(Params P, int layer) {
    const int col = (blockIdx.x * 64 + threadIdx.x) * 4, r0 = blockIdx.y * 16 + threadIdx.y * 4;
    const unsigned* cnt = (const unsigned*)(P.ws + WS_CTL) + CW_CNT + layer * 32;
    int e = -1, base = 0;
    { int a = 0; for (int i = 0; i < NEXP; ++i) { const int pc = ((int)cnt[i] + 255) & ~255; if (r0 >= a && r0 < a + pc) { e = i; base = a; } a += pc; } }
    if (e < 0) return;
    const int n = (int)cnt[e]; const int* LIST = (const int*)(P.ws + WS_LIST) + (size_t)e * NTOK;
    int tok[4]; bool ok[4];
#pragma unroll
    for (int i = 0; i < 4; ++i) { const int s = r0 + i - base; ok[i] = s < n; tok[i] = ok[i] ? (LIST[s] >> 1) : 0; }
    const bf16* H = (const bf16*)(P.ws + WS_H);
    const float* w1 = P.in[I_MW1] + ((size_t)layer * NEXP + e) * DM * MOEH + col; const float* w3 = P.in[I_MW3] + ((size_t)layer * NEXP + e) * DM * MOEH + col;
    f32x4 a1[4], a3[4];
#pragma unroll
    for (int i = 0; i < 4; ++i) { a1[i] = (f32x4){0.f, 0.f, 0.f, 0.f}; a3[i] = a1[i]; }
    for (int k = 0; k < DM; ++k) {
        const f32x4 u = *(const f32x4*)(w1 + (size_t)k * MOEH), w = *(const f32x4*)(w3 + (size_t)k * MOEH);
#pragma unroll
        for (int i = 0; i < 4; ++i) { const float hv = bf2f(H[(size_t)tok[i] * DM + k]); a1[i] += u * hv; a3[i] += w * hv; }
    }
    bf16* ACT = (bf16*)(P.ws + WS_ACT);
#pragma unroll
    for (int i = 0; i < 4; ++i) if (ok[i]) { u32x2 o; o.x = pk2(silu_f(a1[i].x) * a3[i].x, silu_f(a1[i].y) * a3[i].y); o.y = pk2(silu_f(a1[i].z) * a3[i].z, silu_f(a1[i].w) * a3[i].w);
        *(u32x2*)(ACT + (size_t)(r0 + i) * MOEH + col) = o; }
}
__global__ void __launch_bounds__(256) k_moe_down_naive(Params P, int layer) {
    const int col = (blockIdx.x * 64 + threadIdx.x) * 4, r0 = blockIdx.y * 16 + threadIdx.y * 4;
    const unsigned* cnt = (const unsigned*)(P.ws + WS_CTL) + CW_CNT + layer * 32;
    int e = -1, base = 0;
    { int a = 0; for (int i = 0; i < NEXP; ++i) { const int pc = ((int)cnt[i] + 255) & ~255; if (r0 >= a && r0 < a + pc) { e = i; base = a; } a += pc; } }
    if (e < 0) return;
    const int n = (int)cnt[e];
    if (r0 - base >= n) return;
    const bf16* ACT = (const bf16*)(P.ws + WS_ACT) + (size_t)r0 * MOEH;
    const float* w2 = P.in[I_MW2] + ((size_t)layer * NEXP + e) * MOEH * DM + col;
    f32x4 acc[4];
#pragma unroll
    for (int i = 0; i < 4; ++i) acc[i] = (f32x4){0.f, 0.f, 0.f, 0.f};
    for (int k = 0; k < MOEH; ++k) {
        const f32x4 w = *(const f32x4*)(w2 + (size_t)k * DM);
#pragma unroll
        for (int i = 0; i < 4; ++i) acc[i] += w * ((r0 + i - base < n) ? bf2f(ACT[(size_t)i * MOEH + k]) : 0.f);
    }
    bf16* YP = (bf16*)(P.ws + WS_YP);
#pragma unroll
    for (int i = 0; i < 4; ++i) if (r0 + i - base < n) { u32x2 o; o.x = pk2(acc[i].x, acc[i].y); o.y = pk2(acc[i].z, acc[i].w); *(u32x2*)(YP + (size_t)(r0 + i) * DM + col) = o; }
}
__global__ void __launch_bounds__(512) k_swa_naive(Params P, int layer) {
    __shared__ float qs[8][64];
    const int r = blockIdx.x, lane = threadIdx.x & 63, h = threadIdx.x >> 6, kvh = h >> 2, b = r >> 12, t = r & (SEQ - 1), jl = layer >> 1;
    const bf16* QKV = (const bf16*)(P.ws + WS_BIG); const float* BT = (const float*)(P.ws + WS_BT);
    { const float q = bf2f(QKV[(size_t)r * EVN + h * 64 + lane]); const float rs = rsqrtf(wave_sum(q * q) * (1.f / 64.f) + RMS_EPS);
      qs[h][lane] = q * rs * P.in[I_AQN][jl * 64 + lane] * P.in[I_AKN][jl * 64 + lane]; }
    __syncthreads();
    float lg[2];
#pragma unroll
    for (int i = 0; i < 2; ++i) { const int dist = i * 64 + lane, s = t - dist; lg[i] = -INFINITY;
        if (s >= 0) { const bf16* kr = QKV + ((size_t)b * SEQ + s) * EVN + 512 + kvh * 64; float dot = 0.f, kss = 0.f;
#pragma unroll 8
            for (int d = 0; d < 64; ++d) { const float kv = bf2f(kr[d]); dot += qs[h][d] * kv; kss += kv * kv; }
            lg[i] = dot * rsqrtf(kss * (1.f / 64.f) + RMS_EPS) * 0.125f + BT[h * 128 + dist]; } }
    const float sink = P.in[I_ASINK][jl * 8 + h];
    const float m = fmaxf(wave_max(fmaxf(lg[0], lg[1])), sink);
    float p[2];
#pragma unroll
    for (int i = 0; i < 2; ++i) p[i] = (lg[i] == -INFINITY) ? 0.f : __expf(lg[i] - m);
    const float den = wave_sum(p[0] + p[1]) + __expf(sink - m);
    float o = 0.f;
#pragma unroll
    for (int i = 0; i < 2; ++i)
        for (int src = 0; src < 64; ++src) { const float ps = __shfl(p[i], src); const int s = t - (i * 64 + src);
            if (s >= 0) o += ps * bf2f(QKV[((size_t)b * SEQ + s) * EVN + 640 + kvh * 64 + lane]); }
    ((bf16*)(P.ws + WS_MIX))[(size_t)r * DM + h * 64 + lane] = (bf16)f2bf(o / den);
}
__global__ void __launch_bounds__(256) k_gla_decay_naive(Params P, int layer) {
    const int r = blockIdx.x, c = threadIdx.x, jl = layer >> 1;
    const float* ab = (const float*)(P.ws + WS_AB) + (size_t)r * 16; const float* gu = P.in[I_BGU] + (size_t)jl * 16 * 256;
    float z = P.in[I_BGB][jl * 256 + c];
#pragma unroll
    for (int j = 0; j < 16; ++j) z += ab[j] * gu[j * 256 + c];
    ((float*)(P.ws + WS_UPD))[(size_t)r * 256 + c] = __expf(log_sigmoid_f(z) * (1.f / 16.f));
}
__global__ void __launch_bounds__(128) k_gla_scan_naive(Params P, int layer) {
    const int b = blockIdx.x >> 2, h = blockIdx.x & 3, dv = threadIdx.x;
    const bf16* QKV = (const bf16*)(P.ws + WS_BIG); const float* A = (const float*)(P.ws + WS_UPD); float* O = (float*)(P.ws + WS_SIN);
    float S[64];
#pragma unroll
    for (int d = 0; d < 64; ++d) S[d] = 0.f;
    for (int t = 0; t < SEQ; ++t) {
        const size_t r = (size_t)b * SEQ + t;
        const bf16* row = QKV + r * EVN; const float* ar = A + r * 256 + h * 64;
        const float v = bf2f(row[1280 + h * 128 + dv]);
        float o = 0.f;
#pragma unroll
        for (int d = 0; d < 64; ++d) { S[d] = ar[d] * S[d] + bf2f(row[1024 + h * 64 + d]) * v; o += bf2f(row[768 + h * 64 + d]) * S[d]; }
        O[r * 512 + h * 128 + dv] = o * 0.125f;
    }
}
__global__ void __launch_bounds__(256) k_gla_fin_naive(Params P, int layer) {
    const int r = blockIdx.x, lane = threadIdx.x & 63, h = threadIdx.x >> 6, jl = layer >> 1;
    const float* O = (const float*)(P.ws + WS_SIN) + (size_t)r * 512 + h * 128 + 2 * lane; const bf16* QKV = (const bf16*)(P.ws + WS_BIG);
    const float o0 = O[0], o1 = O[1]; const float rs = rsqrtf(wave_sum(o0 * o0 + o1 * o1) * (1.f / 128.f) + RMS_EPS);
    const unsigned g = *(const unsigned*)(QKV + (size_t)r * EVN + 1792 + h * 128 + 2 * lane);
    const float* on = P.in[I_BON] + jl * 128 + 2 * lane;
    *(unsigned*)((bf16*)(P.ws + WS_MIX) + (size_t)r * DM + 512 + h * 128 + 2 * lane) = pk2(o0 * rs * on[0] * silu_f(bflo(g)), o1 * rs * on[1] * silu_f(bfhi(g)));
}
__global__ void __launch_bounds__(512) k_moba_naive(Params P, int layer) {
    __shared__ float qs[8][128];
    const int r = blockIdx.x, lane = threadIdx.x & 63, h = threadIdx.x >> 6, b = r >> 12, t = r & (SEQ - 1), qblk = t >> 8, jl = layer >> 1;
    const bf16* QKV = (const bf16*)(P.ws + WS_BIG); const float* BT = (const float*)(P.ws + WS_BT) + h * 128; const float* KM = (const float*)(P.ws + WS_KMEAN);
    { const unsigned u = *(const unsigned*)(QKV + (size_t)r * ODN + h * 128 + 2 * lane); const float q0 = bflo(u), q1 = bfhi(u);
      const float rs = rsqrtf(wave_sum(q0 * q0 + q1 * q1) * (1.f / 128.f) + RMS_EPS); const float* qn = P.in[I_CQN] + jl * 128 + 2 * lane;
      qs[h][2 * lane] = q0 * rs * qn[0]; qs[h][2 * lane + 1] = q1 * rs * qn[1]; }
    __syncthreads();
    float sc = -INFINITY;
    if (lane < qblk) { const float* km = KM + (((size_t)b * 16 + lane) * 8 + h) * 128; float d = 0.f; for (int i = 0; i < 128; ++i) d += qs[h][i] * km[i]; sc = d; }
    int blk[4]; blk[0] = qblk;
#pragma unroll
    for (int n = 0; n < 3; ++n) { const float mx = wave_max(sc); const unsigned long long bal = __ballot(sc == mx && mx > -INFINITY);
        const int idx = bal ? (__ffsll((long long)bal) - 1) : -1; blk[1 + n] = idx; if (lane == idx) sc = -INFINITY; }
    float lg[4][4];
#pragma unroll
    for (int s = 0; s < 4; ++s)
#pragma unroll
        for (int rr = 0; rr < 4; ++rr) { lg[s][rr] = -INFINITY;
            if (blk[s] >= 0) { const int key = blk[s] * 256 + rr * 64 + lane, dist = t - key;
                if (dist >= 0) { const bf16* kr = QKV + ((size_t)b * SEQ + key) * ODN + 1024 + h * 128; float dot = 0.f;
#pragma unroll 8
                    for (int d = 0; d < 128; ++d) dot += qs[h][d] * bf2f(kr[d]);
                    lg[s][rr] = dot * 0.08838834764831845f + BT[dist < 127 ? dist : 127]; } } }
    float m = -INFINITY;
#pragma unroll
    for (int s = 0; s < 4; ++s)
#pragma unroll
        for (int rr = 0; rr < 4; ++rr) m = fmaxf(m, lg[s][rr]);
    m = wave_max(m);
    float den = 0.f;
#pragma unroll
    for (int s = 0; s < 4; ++s)
#pragma unroll
        for (int rr = 0; rr < 4; ++rr) { lg[s][rr] = (lg[s][rr] == -INFINITY) ? 0.f : __expf(lg[s][rr] - m); den += lg[s][rr]; }
    den = wave_sum(den);
    float o0 = 0.f, o1 = 0.f;
#pragma unroll
    for (int s = 0; s < 4; ++s)
#pragma unroll
        for (int rr = 0; rr < 4; ++rr) {
            if (blk[s] < 0) continue;
            for (int src = 0; src < 64; ++src) { const float ps = __shfl(lg[s][rr], src); const int key = blk[s] * 256 + rr * 64 + src;
                if (key <= t) { const unsigned u = *(const unsigned*)(QKV + ((size_t)b * SEQ + key) * ODN + 2048 + h * 128 + 2 * lane); o0 += ps * bflo(u); o1 += ps * bfhi(u); } } }
    *(unsigned*)((bf16*)(P.ws + WS_MIX) + (size_t)r * DM + h * 128 + 2 * lane) = pk2(o0 / den, o1 / den);
}

#define XB_TMO      128
#define XB_XCNT(j)  (256  + 64 * (j))
#define XB_XSUB(j)  (1280 + 64 * (j))
#define XB_XGEN(j)  (2304 + 64 * (j))
#define XB_TOP      3328
#define XB_TOPGEN   3392
#define XCD_BAR_WORDS 3456
#define XB_SPIN_CAP (1u << 18)
#define LAS __attribute__((address_space(3)))

__device__ __forceinline__ unsigned xb_ld(unsigned* p)              { return __hip_atomic_load(p, __ATOMIC_RELAXED, __HIP_MEMORY_SCOPE_AGENT); }
__device__ __forceinline__ unsigned xb_add(unsigned* p, unsigned v) { return __hip_atomic_fetch_add(p, v, __ATOMIC_RELAXED, __HIP_MEMORY_SCOPE_AGENT); }
__device__ __forceinline__ unsigned xb_xcc_id() { return (unsigned)__builtin_amdgcn_s_getreg((3 << 11) | 20) & 0xFu; }
#define XB_SPIN(cond, bar) do { unsigned _sp = 0; while (cond) { __builtin_amdgcn_s_sleep(1); \
    if ((++_sp & 255u) == 0u) { if (xb_ld(&(bar)[XB_TMO])) break; if (_sp > XB_SPIN_CAP) { atomicAdd(&(bar)[XB_TMO], 1u); break; } } } } while (0)

struct XcdBarrier {
    unsigned* bar; unsigned x;
    volatile LAS unsigned* st;
};
__device__ __forceinline__ XcdBarrier xcd_barrier_post(unsigned* bar, volatile LAS unsigned* st) {
    XcdBarrier b; b.bar = bar; b.x = xb_xcc_id(); b.st = st;
    if (threadIdx.x == 0) (void)xb_add(&bar[XB_XCNT(b.x)], 1u);
    return b;
}
__device__ __forceinline__ void xcd_barrier_complete(unsigned* bar, unsigned x, unsigned& nloc, unsigned& nx) {
    const unsigned G = gridDim.x * gridDim.y * gridDim.z;
    unsigned sum, cnt, mine, sp = 0u;
    for (;;) {
        sum = 0u; cnt = 0u; mine = 0u;
#pragma unroll
        for (unsigned j = 0; j < 16; ++j) { const unsigned c = xb_ld(&bar[XB_XCNT(j)]); sum += c; cnt += (c > 0u) ? 1u : 0u; mine = (j == x) ? c : mine; }
        if (sum == G) break;
        __builtin_amdgcn_s_sleep(1);
        if ((++sp & 255u) == 0u) { if (xb_ld(&bar[XB_TMO])) break; if (sp > XB_SPIN_CAP) { atomicAdd(&bar[XB_TMO], 1u); break; } }
    }
    nloc = mine > 0u ? mine : 1u; nx = cnt > 0u ? cnt : 1u;
}
__device__ __forceinline__ void xcd_barrier(const XcdBarrier& b) {
    asm volatile("s_waitcnt vmcnt(0)" ::: "memory");
    __syncthreads();
    if (threadIdx.x == 0) {
        unsigned* bar = b.bar;
        __builtin_amdgcn_s_waitcnt(0);
        unsigned nloc = b.st[0], nx = b.st[1];
        if (nloc == 0u) { xcd_barrier_complete(bar, b.x, nloc, nx); b.st[0] = nloc; b.st[1] = nx; }
        const unsigned old = xb_add(&bar[XB_XSUB(b.x)], 1u);
        const unsigned gen = old / nloc;
        if (old + 1u == (gen + 1u) * nloc) {
            __builtin_amdgcn_fence(__ATOMIC_RELEASE, "agent");
            asm volatile("s_waitcnt vmcnt(0)" ::: "memory");
            const unsigned og = xb_add(&bar[XB_TOP], 1u);
            const unsigned tg = og / nx;
            if (og + 1u == (tg + 1u) * nx) xb_add(&bar[XB_TOPGEN], 1u);
            else XB_SPIN(xb_ld(&bar[XB_TOPGEN]) == tg, bar);
            __builtin_amdgcn_fence(__ATOMIC_ACQUIRE, "agent");
            xb_add(&bar[XB_XGEN(b.x)], 1u);
            asm volatile("s_waitcnt vmcnt(0)" ::: "memory");
        } else {
            XB_SPIN(xb_ld(&bar[XB_XGEN(b.x)]) == gen, bar);
            __builtin_amdgcn_fence(__ATOMIC_ACQUIRE, "agent");
            asm volatile("s_waitcnt vmcnt(0)" ::: "memory");
        }
    }
    __syncthreads();
}

constexpr int LDS_AUX_OFF = 147456, LDS_MISC_OFF = 151552, LDS_BYTES = 155648;
constexpr int N_PHASES = 36;
__global__ void __launch_bounds__(512, 2) mega(Params P) {
    extern __shared__ __attribute__((aligned(16))) unsigned char lds[];
    const int tid = threadIdx.x;
    const int G = gridDim.x, bx = blockIdx.x, vcu = (G % 8 == 0) ? (bx % 8) * (G / 8) + bx / 8 : bx;
    volatile LAS unsigned* MISC = (volatile LAS unsigned*)(lds + LDS_MISC_OFF);
    if (tid < 8) MISC[tid] = 0u;
    __syncthreads();
    unsigned* ctl = (unsigned*)(P.ws + WS_CTL);
    const XcdBarrier bar = xcd_barrier_post(ctl + CW_BAR + P.li * XCD_BAR_WORDS, MISC);
    const int lo = P.ph_lo, hi = P.ph_hi; int ph = 0;
    float* X = P.out; float* MOD = (float*)(P.ws + WS_MOD);
    bf16* H = (bf16*)(P.ws + WS_H); bf16* QKV = (bf16*)(P.ws + WS_BIG); bf16* MIX = (bf16*)(P.ws + WS_MIX); bf16* ACT = (bf16*)(P.ws + WS_ACT); bf16* YP = (bf16*)(P.ws + WS_YP);
    PG8_LAS unsigned char* ldsg = (PG8_LAS unsigned char*)lds;
#define PH_BEGIN if (ph >= lo && ph < hi) {
#define PH_END if (ph + 1 < hi) xcd_barrier(bar); } ++ph;
    PH_BEGIN phase_prologue(P, lds, vcu, G, true); PH_END
#pragma unroll 1
    for (int l = 0; l <= DEPTH; ++l) {
        const int odd = l & 1, lp = l >> 1;
        bool done = false;
#pragma unroll 1
        for (int half = 0; half < 2 && !done; ++half) {
            PH_BEGIN
                { const int mode = (l == DEPTH) ? 0 : (half ? 3 : (odd ? 2 : 1));
                  phase_norm(P, lds, vcu, G, mode, l, (l == 0 && !half) ? P.in[I_X] : (const float*)X, half ? (float*)nullptr : X, half ? -1 : l - 1); }
            PH_END
            if (l == DEPTH) { done = true; continue; }
            if (!half) {
                PH_BEGIN
                    { const int N = odd ? ODN : EVN; const bf16* wt = odd ? (const bf16*)(P.ws + WS_WOI) + (size_t)lp * ODN * DM : (const bf16*)(P.ws + WS_WEI) + (size_t)lp * EVN * DM;
                      pg8::Gemm g{H, wt, DM, 0}; pg8::StaticOrder S; S.init(NTOK, N, G, bx); pg8::EpiBf16 E{QKV, N}; pg8::gemm_phase(ldsg, g, S, E); }
                PH_END
                if (!odd) {
                    PH_BEGIN att::phase_swa(P, lds, vcu, G, l); att::phase_gla_local(P, lds, vcu, G, l); PH_END
                    PH_BEGIN att::phase_gla_scan(P, vcu, G); PH_END
                    PH_BEGIN att::phase_gla_final(P, lds, vcu, G, l); PH_END
                } else {
                    PH_BEGIN phase_kprep(P, lds, vcu, G, l); PH_END
                    PH_BEGIN att::phase_moba(P, lds, vcu, G, l); PH_END
                }
                PH_BEGIN
                    { pg8::Gemm g{MIX, (const bf16*)(P.ws + (odd ? WS_WOO : WS_WEO)) + (size_t)lp * DM * DM, DM, 0}; pg8::StaticOrder S; S.init(NTOK, DM, G, bx);
                      pg8::EpiResid E{(l == 0) ? P.in[I_X] : (const float*)X, X, MOD + (size_t)l * NBATCH * 6 * DM + 2 * DM}; pg8::gemm_phase(ldsg, g, S, E); }
                PH_END
            } else {
#pragma unroll 1
                for (int dn = 0; dn < 2; ++dn) {
                    PH_BEGIN
                        { const int tid = opaque_tid(); PG8_LAS int* tp = (PG8_LAS int*)(ldsg + LDS_AUX_OFF); PG8_LAS unsigned* cl = (PG8_LAS unsigned*)(tp + 64); const unsigned* cnt = ctl + CW_CNT + l * 32;
                          if (tid == 0) { int a = 0; for (int e = 0; e < NEXP; ++e) { tp[e] = a; a += ((int)cnt[e] + 255) >> 8; } tp[NEXP] = a; }
                          if (tid < 32) cl[tid] = cnt[tid];
                          __syncthreads();
                          if (!dn) { pg8::Gemm g{H, (const bf16*)(P.ws + WS_WUP) + (size_t)l * NEXP * 1024 * DM, DM, (size_t)1024 * DM};
                              pg8::MoeOrder<true> S{tp, cl, (const int*)(P.ws + WS_LIST), tp + 256, 4, G, vcu}; pg8::EpiSiluMul E{ACT}; pg8::gemm_phase(ldsg, g, S, E); }
                          else { pg8::Gemm g{ACT, (const bf16*)(P.ws + WS_WDN) + (size_t)l * NEXP * DM * MOEH, MOEH, (size_t)DM * MOEH};
                              pg8::MoeOrder<false> S{tp, cl, (const int*)(P.ws + WS_LIST), tp + 256, 4, G, vcu}; pg8::EpiBf16 E{YP, DM}; pg8::gemm_phase(ldsg, g, S, E); } }
                    PH_END
                }
            }
        }
    }
#undef PH_BEGIN
#undef PH_END
}

extern "C" void kernel_launch(void* const* d_in, const int* in_sizes, int n_in, void* d_out, int out_size, void* d_ws, size_t ws_size, hipStream_t stream) {
    static int ok = 0, grid = 0;
    constexpr int LDS_NORM = LDS_BYTES;
    if (ok == 0) {
        if (n_in != N_IN || out_size != NTOK * DM || ws_size < WS_END) { fprintf(stderr, "kernel_launch: unexpected shapes (n_in %d out %d ws %zu need %zu)\n", n_in, out_size, ws_size, (size_t)WS_END); ok = -1; return; }
        int dev = 0, cus = 0;
        if (hipGetDevice(&dev) != hipSuccess || hipDeviceGetAttribute(&cus, hipDeviceAttributeMultiprocessorCount, dev) != hipSuccess) { ok = -1; return; }
        if (hipFuncSetAttribute((const void*)k_norm, hipFuncAttributeMaxDynamicSharedMemorySize, LDS_NORM) != hipSuccess) { fprintf(stderr, "kernel_launch: hipFuncSetAttribute failed\n"); ok = -1; return; }
        if (hipFuncSetAttribute((const void*)mega, hipFuncAttributeMaxDynamicSharedMemorySize, LDS_BYTES) != hipSuccess) { fprintf(stderr, "kernel_launch: hipFuncSetAttribute(mega) failed\n"); ok = -1; return; }
        int per_cu = 0;
        if (hipOccupancyMaxActiveBlocksPerMultiprocessor(&per_cu, (const void*)mega, 512, LDS_BYTES) != hipSuccess || per_cu < 1) fprintf(stderr, "kernel_launch: occupancy query says %d blocks per CU\n", per_cu);
        (void)hipGetLastError();
        grid = cus;
        ok = 1;
    }
    if (ok < 0) return;
    Params P{};
    for (int i = 0; i < N_IN; ++i) P.in[i] = (const float*)d_in[i];
    P.out = (float*)d_out; P.ws = (unsigned char*)d_ws; P.ph_lo = 0; P.ph_hi = 0; P.li = 0; P.pad = 0;
    (void)hipMemsetAsync((char*)d_ws + WS_CTL, 0, CTL_BYTES, stream);
    int li = 0;
    auto run = [&](int lo, int hi) { P.ph_lo = lo; P.ph_hi = hi; P.li = li++; hipLaunchKernelGGL(mega, dim3(grid), dim3(512), LDS_BYTES, stream, P); };
#if 0
    run(0, 1);
    for (int lp = 0; lp < 2; ++lp) {
        const int base = 1 + lp * 17, le = 2 * lp, lo_ = 2 * lp + 1;
        run(base + 0, base + 2);
        hipLaunchKernelGGL(k_swa_naive, dim3(NTOK), dim3(512), 0, stream, P, le);
        hipLaunchKernelGGL(k_gla_decay_naive, dim3(NTOK), dim3(256), 0, stream, P, le);
        hipLaunchKernelGGL(k_gla_scan_naive, dim3(32), dim3(128), 0, stream, P, le);
        hipLaunchKernelGGL(k_gla_fin_naive, dim3(NTOK), dim3(256), 0, stream, P, le);
        run(base + 5, base + 9);
        run(base + 9, base + 17);
    }
    run(35, 36);
#else
    run(0, N_PHASES);
#endif
}
```

```cpp
#include <hip/hip_runtime.h>
#include <cstdio>
#include <cstdint>

#define DEV __device__ __forceinline__
typedef unsigned short bf16;
typedef float f32x4 __attribute__((ext_vector_type(4)));
typedef float f32x2 __attribute__((ext_vector_type(2)));
typedef unsigned u32x2 __attribute__((ext_vector_type(2)));
typedef unsigned u32x4 __attribute__((ext_vector_type(4)));

constexpr int DM = 1024, NBATCH = 8, SEQ = 4096, NTOK = NBATCH * SEQ, DEPTH = 4;
constexpr int EVEN_IN = 2320, EVN = 2304, ODN = 3072;
constexpr int NEXP = 32, MOEH = 512, NPAIR = 2 * NTOK, MOE_ROWS = 73728;
constexpr float RMS_EPS = 1e-6f;
enum { I_X = 0, I_C, I_RELB, I_ADAW, I_ADAB, I_N1W, I_N2W, I_EWIN, I_EWOUT, I_AQN, I_AKN, I_ASINK, I_BGU, I_BGB, I_BON, I_OWIN, I_OWOUT, I_CQN, I_CKN,
       I_MWG, I_MBG, I_MWE, I_MBE, I_MW1, I_MW3, I_MW2, N_IN };
struct Params { const float* in[N_IN]; float* out; unsigned char* ws; int ph_lo, ph_hi, li, pad; };

constexpr size_t al256(size_t x) { return (x + 255) & ~(size_t)255; }
constexpr size_t WS_CTL = 0, CTL_BYTES = 1u << 20;
constexpr size_t WS_MOD = WS_CTL + CTL_BYTES;
constexpr size_t WS_BT = WS_MOD + al256((size_t)DEPTH * NBATCH * 6 * DM * 4);
constexpr size_t WS_KMEAN = WS_BT + al256(8 * 128 * 4);
constexpr size_t WS_AB = WS_KMEAN + al256((size_t)NBATCH * 16 * 8 * 128 * 4);
constexpr size_t WS_PAIRE = WS_AB + al256((size_t)NTOK * 16 * 4);
constexpr size_t WS_PAIRS = WS_PAIRE + al256((size_t)NPAIR * 4);
constexpr size_t WS_PAIRG = WS_PAIRS + al256((size_t)NPAIR * 4);
constexpr size_t WS_LIST = WS_PAIRG + al256((size_t)NPAIR * 4);
constexpr size_t WS_WEI = WS_LIST + al256((size_t)NEXP * NTOK * 4);
constexpr size_t WS_WEO = WS_WEI + al256((size_t)2 * EVN * DM * 2);
constexpr size_t WS_WOI = WS_WEO + al256((size_t)2 * DM * DM * 2);
constexpr size_t WS_WOO = WS_WOI + al256((size_t)2 * ODN * DM * 2);
constexpr size_t WS_WUP = WS_WOO + al256((size_t)2 * DM * DM * 2);
constexpr size_t WS_WDN = WS_WUP + al256((size_t)DEPTH * NEXP * 1024 * DM * 2);
constexpr size_t WS_H = WS_WDN + al256((size_t)DEPTH * NEXP * DM * MOEH * 2);
constexpr size_t WS_MIX = WS_H + al256((size_t)NTOK * DM * 2);
constexpr size_t WS_UPD = WS_MIX + al256((size_t)NTOK * DM * 2);
constexpr size_t WS_SIN = WS_UPD + al256((size_t)2048 * 64 * 128 * 4);
constexpr size_t WS_DEC = WS_SIN + al256((size_t)2048 * 64 * 128 * 4);
constexpr size_t WS_BIG = WS_DEC + al256((size_t)2048 * 64 * 4);
constexpr size_t WS_ACT = WS_BIG, WS_YP = WS_BIG + al256((size_t)MOE_ROWS * MOEH * 2);
constexpr size_t BIG_BYTES = al256((size_t)MOE_ROWS * MOEH * 2) + al256((size_t)MOE_ROWS * DM * 2);
static_assert(BIG_BYTES >= (size_t)NTOK * ODN * 2, "QKV fits the union");
constexpr size_t WS_END = WS_BIG + BIG_BYTES;
constexpr int CW_CNT = 64;
constexpr int CW_BAR = 4096;

__device__ const unsigned char REL_BUCKET[128] = {0,1,2,3,4,5,6,7,8,9,10,11,12,13,14,15,16,16,16,17,17,18,18,18,19,19,19,20,20,20,20,21,21,21,21,22,22,22,22,22,23,23,23,23,23,23,24,24,24,24,24,24,25,25,25,25,25,25,25,26,26,26,26,26,26,26,26,27,27,27,27,27,27,27,27,27,27,28,28,28,28,28,28,28,28,28,28,29,29,29,29,29,29,29,29,29,29,29,29,30,30,30,30,30,30,30,30,30,30,30,30,30,30,31,31,31,31,31,31,31,31,31,31,31,31,31,31,31};

DEV int opaque_tid() { int t = threadIdx.x; asm volatile("" : "+v"(t)); return t; }
DEV float bf2f(bf16 v) { return __uint_as_float((unsigned)v << 16); }
DEV float bflo(unsigned u) { return __uint_as_float(u << 16); }
DEV float bfhi(unsigned u) { return __uint_as_float(u & 0xffff0000u); }
DEV unsigned f2bf(float f) { unsigned u = __float_as_uint(f); return (u + 0x7fffu + ((u >> 16) & 1u)) >> 16; }
DEV unsigned pk2(float lo, float hi) { return f2bf(lo) | (f2bf(hi) << 16); }
DEV float wave_sum(float v) {
#pragma unroll
    for (int o = 1; o < 64; o <<= 1) v += __shfl_xor(v, o);
    return v;
}
DEV float wave_max(float v) {
#pragma unroll
    for (int o = 1; o < 64; o <<= 1) v = fmaxf(v, __shfl_xor(v, o));
    return v;
}
DEV float silu_f(float x) { return x / (1.f + __expf(-x)); }
DEV float log_sigmoid_f(float x) { return fminf(x, 0.f) - log1pf(__expf(-fabsf(x))); }
DEV void moe_rowbase(const unsigned* cnt, int* rb  ) { int a = 0; for (int e = 0; e < NEXP; ++e) { rb[e] = a; a += ((int)cnt[e] + 255) & ~255; } rb[NEXP] = a; }

DEV void phase_prologue(const Params& P, unsigned char* lds, int vb, int nvb, bool with_weights) {
    const int tid = opaque_tid(), lane = tid & 63, wave = tid >> 6;
    float* cond = (float*)lds;
    float* red = (float*)(lds + 32768);
    const float* c = P.in[I_C];
    for (int i = tid; i < NBATCH * DM; i += 512) cond[i] = silu_f(c[i]);
    __syncthreads();
    float* MOD = (float*)(P.ws + WS_MOD);
    const float* adaw = P.in[I_ADAW]; const float* adab = P.in[I_ADAB];
    for (int u = vb; u < DEPTH * 96; u += nvb) {
        const int l = u / 96, col = (u % 96) * 64 + lane;
        float acc[8];
#pragma unroll
        for (int b = 0; b < 8; ++b) acc[b] = 0.f;
        const float* wp = adaw + ((size_t)l * DM + wave * 128) * (6 * DM) + col;
#pragma unroll 4
        for (int k = 0; k < 128; ++k) {
            const float w = wp[(size_t)k * (6 * DM)];
#pragma unroll
            for (int b = 0; b < 8; ++b) acc[b] += cond[b * DM + wave * 128 + k] * w;
        }
#pragma unroll
        for (int b = 0; b < 8; ++b) red[(wave * 8 + b) * 64 + lane] = acc[b];
        __syncthreads();
        {
            float s = 0.f;
#pragma unroll
            for (int w = 0; w < 8; ++w) s += red[(w * 8 + wave) * 64 + lane];
            MOD[((size_t)l * NBATCH + wave) * (6 * DM) + col] = s + adab[(size_t)l * 6 * DM + col];
        }
        __syncthreads();
    }
    if (vb == 0) {
        float* BT = (float*)(P.ws + WS_BT); const float* rb = P.in[I_RELB];
        for (int i = tid; i < 8 * 128; i += 512) { const int h = i >> 7, d = i & 127; BT[i] = rb[REL_BUCKET[d] * 8 + h]; }
    }
    if (!with_weights) return;
    float* scr = (float*)(lds + 49152 + wave * 8448);
    constexpr int IT_EI = 2 * 16 * 72, IT_EO = 2 * 16 * 32, IT_OI = 2 * 16 * 96, IT_OO = 2 * 16 * 32, IT_W = DEPTH * NEXP * 256;
    constexpr int NITEMS = IT_EI + IT_EO + IT_OI + IT_OO + 3 * IT_W;
    for (int it = vb * 8 + wave; it < NITEMS; it += nvb * 8) {
        int r = it; const float* W; int ldw, k0, n0, K = DM, drow0; bf16* WT;
        if (r < IT_EI) { const int jl = r / 1152, rr = r % 1152; k0 = (rr / 72) * 64; n0 = (rr % 72) * 32; W = P.in[I_EWIN] + (size_t)jl * DM * EVEN_IN; ldw = EVEN_IN; WT = (bf16*)(P.ws + WS_WEI) + (size_t)jl * EVN * DM; drow0 = n0; }
        else if ((r -= IT_EI) < IT_EO) { const int jl = r / 512, rr = r % 512; k0 = (rr / 32) * 64; n0 = (rr % 32) * 32; W = P.in[I_EWOUT] + (size_t)jl * DM * DM; ldw = DM; WT = (bf16*)(P.ws + WS_WEO) + (size_t)jl * DM * DM; drow0 = n0; }
        else if ((r -= IT_EO) < IT_OI) { const int jl = r / 1536, rr = r % 1536; k0 = (rr / 96) * 64; n0 = (rr % 96) * 32; W = P.in[I_OWIN] + (size_t)jl * DM * ODN; ldw = ODN; WT = (bf16*)(P.ws + WS_WOI) + (size_t)jl * ODN * DM; drow0 = n0; }
        else if ((r -= IT_OI) < IT_OO) { const int jl = r / 512, rr = r % 512; k0 = (rr / 32) * 64; n0 = (rr % 32) * 32; W = P.in[I_OWOUT] + (size_t)jl * DM * DM; ldw = DM; WT = (bf16*)(P.ws + WS_WOO) + (size_t)jl * DM * DM; drow0 = n0; }
        else if ((r -= IT_OO) < 2 * IT_W) { const int w3 = r >= IT_W; if (w3) r -= IT_W; const int le = r >> 8, rr = r & 255; k0 = (rr >> 4) * 64; n0 = (rr & 15) * 32;
            W = P.in[w3 ? I_MW3 : I_MW1] + (size_t)le * DM * MOEH; ldw = MOEH; WT = (bf16*)(P.ws + WS_WUP) + (size_t)le * 1024 * DM; drow0 = (n0 >> 7) * 256 + (n0 & 127) + (w3 ? 128 : 0); }
        else { r -= 2 * IT_W; const int le = r >> 8, rr = r & 255; k0 = (rr >> 5) * 64; n0 = (rr & 31) * 32; W = P.in[I_MW2] + (size_t)le * MOEH * DM; ldw = DM; K = MOEH; WT = (bf16*)(P.ws + WS_WDN) + (size_t)le * DM * MOEH; drow0 = n0; }
#pragma unroll 8
        for (int i = 0; i < 32; ++i) { const int kk = 2 * i + (lane >> 5); scr[kk * 33 + (lane & 31)] = W[(size_t)(k0 + kk) * ldw + n0 + (lane & 31)]; }
        asm volatile("s_waitcnt lgkmcnt(0)" ::: "memory");
        const int c = lane & 7;
#pragma unroll
        for (int j = 0; j < 4; ++j) { const int n = (lane >> 3) + 8 * j; const float* s = scr + (8 * c) * 33 + n;
            u32x4 o; o.x = pk2(s[0 * 33], s[1 * 33]); o.y = pk2(s[2 * 33], s[3 * 33]); o.z = pk2(s[4 * 33], s[5 * 33]); o.w = pk2(s[6 * 33], s[7 * 33]);
            *(u32x4*)(WT + (size_t)(drow0 + n) * K + k0 + 8 * c) = o; }
        asm volatile("s_waitcnt lgkmcnt(0)" ::: "memory");
    }
}

constexpr int NT_TS = 1028;
constexpr int NT_MISC = 148480;
DEV float rs16(const float (&a)[16], int lane) {
    float b8[8], b4[4], b2[2];
    const bool u32_ = lane & 32, u16_ = lane & 16, u8_ = lane & 8, u4_ = lane & 4;
#pragma unroll
    for (int i = 0; i < 8; ++i) { const float keep = u32_ ? a[8 + i] : a[i], send = u32_ ? a[i] : a[8 + i]; b8[i] = keep + __shfl_xor(send, 32); }
#pragma unroll
    for (int i = 0; i < 4; ++i) { const float keep = u16_ ? b8[4 + i] : b8[i], send = u16_ ? b8[i] : b8[4 + i]; b4[i] = keep + __shfl_xor(send, 16); }
#pragma unroll
    for (int i = 0; i < 2; ++i) { const float keep = u8_ ? b4[2 + i] : b4[i], send = u8_ ? b4[i] : b4[2 + i]; b2[i] = keep + __shfl_xor(send, 8); }
    float r = (u4_ ? b2[1] : b2[0]) + __shfl_xor(u4_ ? b2[0] : b2[1], 4);
    r += __shfl_xor(r, 1); r += __shfl_xor(r, 2);
    return r;
}
DEV void phase_norm(const Params& P, unsigned char* lds, int vb, int nvb, int mode, int layer, const float* xsrc, float* xdst, int clayer  , int dry = 0) {
    const int tid = opaque_tid(), lane = tid & 63, wave = tid >> 6;
    float* tab = (float*)lds;
    int* lcnt = (int*)(lds + NT_MISC);
    int* lbase = lcnt + 32;
    int* rowb = lbase + 32;
    int* plist = rowb + 64;
    int* pn = plist + 512;
    const unsigned* ctl = (const unsigned*)(P.ws + WS_CTL);
    float* MOD = (float*)(P.ws + WS_MOD);
    if (mode == 1) { const float* w = P.in[I_EWIN] + (size_t)(layer >> 1) * DM * EVEN_IN;
        for (int i = tid; i < DM * 16; i += 512) { const int k = i >> 4, j = i & 15; tab[j * NT_TS + k] = w[(size_t)k * EVEN_IN + EVN + j]; } }
    if (mode == 3) { const float* wg = P.in[I_MWG] + (size_t)layer * DM * 4; const float* we = P.in[I_MWE] + (size_t)layer * DM * 32;
        for (int i = tid; i < DM * 4; i += 512) { const int k = i >> 2, j = i & 3; tab[j * NT_TS + k] = wg[i]; }
        for (int i = tid; i < DM * 32; i += 512) { const int k = i >> 5, j = i & 31; tab[(4 + j) * NT_TS + k] = we[i]; }
        if (tid < 32) lcnt[tid] = 0; if (tid == 0) pn[0] = 0; }
    if (clayer >= 0 && tid == 0) moe_rowbase(ctl + CW_CNT + clayer * 32, rowb);
    __syncthreads();
    const int* PE = (const int*)(P.ws + WS_PAIRE); const int* PS = (const int*)(P.ws + WS_PAIRS); const float* PG = (const float*)(P.ws + WS_PAIRG);
    const bf16* YP = (const bf16*)(P.ws + WS_YP);
    bf16* H = (bf16*)(P.ws + WS_H);
    const int NQ = (mode == 1) ? 16 : 36;
    for (int p = vb * 8 + wave; p < NTOK / 2; p += nvb * 8) {
        const int b = (2 * p) >> 12;
        f32x4 v[2][4];
#pragma unroll
        for (int rr = 0; rr < 2; ++rr)
#pragma unroll
            for (int j = 0; j < 4; ++j) v[rr][j] = *(const f32x4*)(xsrc + (size_t)(2 * p + rr) * DM + j * 256 + lane * 4);
        if (clayer >= 0) {
            const float* gate2 = MOD + ((size_t)clayer * NBATCH + b) * (6 * DM) + 5 * DM;
#pragma unroll
            for (int rr = 0; rr < 2; ++rr) { const int r = 2 * p + rr;
                const int e0 = PE[2 * r], e1 = PE[2 * r + 1]; const float g0 = PG[2 * r], g1 = PG[2 * r + 1];
                const size_t p0 = (size_t)(rowb[e0] + PS[2 * r]), p1 = (size_t)(rowb[e1] + PS[2 * r + 1]);
#pragma unroll
                for (int j = 0; j < 4; ++j) {
                    const u32x2 y0 = *(const u32x2*)(YP + p0 * DM + j * 256 + lane * 4), y1 = *(const u32x2*)(YP + p1 * DM + j * 256 + lane * 4);
                    const f32x4 g = *(const f32x4*)(gate2 + j * 256 + lane * 4);
                    f32x4 m;
                    m.x = g0 * bflo(y0.x) + g1 * bflo(y1.x); m.y = g0 * bfhi(y0.x) + g1 * bfhi(y1.x);
                    m.z = g0 * bflo(y0.y) + g1 * bflo(y1.y); m.w = g0 * bfhi(y0.y) + g1 * bfhi(y1.y);
                    v[rr][j] = v[rr][j] + g * m;
                    if (xdst && !dry) *(f32x4*)(xdst + (size_t)r * DM + j * 256 + lane * 4) = v[rr][j];
                } }
        }
        if (mode == 0) continue;
        const float* nw = P.in[mode == 3 ? I_N2W : I_N1W] + (size_t)layer * DM;
        const float* modr = MOD + ((size_t)layer * NBATCH + b) * (6 * DM) + (mode == 3 ? 3 * DM : 0);
#pragma unroll
        for (int rr = 0; rr < 2; ++rr) {
            float ss = 0.f;
#pragma unroll
            for (int j = 0; j < 4; ++j) ss += (v[rr][j].x * v[rr][j].x + v[rr][j].y * v[rr][j].y) + (v[rr][j].z * v[rr][j].z + v[rr][j].w * v[rr][j].w);
            const float rstd = rsqrtf(wave_sum(ss) * (1.f / DM) + RMS_EPS);
#pragma unroll
            for (int j = 0; j < 4; ++j) {
                const int c0 = j * 256 + lane * 4;
                const f32x4 w = *(const f32x4*)(nw + c0), sh = *(const f32x4*)(modr + c0), sc = *(const f32x4*)(modr + DM + c0);
                v[rr][j] = (v[rr][j] * rstd * w) * (sc + 1.f) + sh;
                u32x2 o; o.x = pk2(v[rr][j].x, v[rr][j].y); o.y = pk2(v[rr][j].z, v[rr][j].w);
                if (!dry) *(u32x2*)(H + (size_t)(2 * p + rr) * DM + c0) = o;
            }
        }
        if (mode == 2) continue;
        float val[5];
#pragma unroll
        for (int gq = 0; gq < 5; ++gq) {
            val[gq] = 0.f;
            if (gq * 8 < NQ) {
                float acc[16];
#pragma unroll
                for (int i = 0; i < 8; ++i) { const int q = gq * 8 + i; acc[i] = 0.f; acc[8 + i] = 0.f;
                    if (q < 36 && q < NQ) {
                        f32x4 s0 = (f32x4){0.f, 0.f, 0.f, 0.f}, s1 = s0;
#pragma unroll
                        for (int j = 0; j < 4; ++j) { const f32x4 t = *(const f32x4*)(tab + q * NT_TS + j * 256 + lane * 4); s0 += v[0][j] * t; s1 += v[1][j] * t; }
                        acc[i] = (s0.x + s0.y) + (s0.z + s0.w); acc[8 + i] = (s1.x + s1.y) + (s1.z + s1.w); }
                    if (i & 1) __builtin_amdgcn_sched_barrier(0); }
                val[gq] = rs16(acc, lane);
            }
        }
        const int rowsel = lane >> 5, r = 2 * p + rowsel, sub = (lane >> 2) & 7;
        if (mode == 1) {
            if ((lane & 3) == 0 && !dry) { float* ab = (float*)(P.ws + WS_AB) + (size_t)r * 16; ab[sub] = val[0]; ab[8 + sub] = val[1]; }
            continue;
        }
        {
            const int rb32 = rowsel * 32;
            const float* bg = P.in[I_MBG] + layer * 4; const float* be = P.in[I_MBE] + layer * 32;
            float gl[4];
#pragma unroll
            for (int i = 0; i < 4; ++i) gl[i] = __shfl(val[0], rb32 + 4 * i) + bg[i];
            int g = 0; float gm = gl[0];
#pragma unroll
            for (int i = 1; i < 4; ++i) if (gl[i] > gm) { gm = gl[i]; g = i; }
            float den = 0.f;
#pragma unroll
            for (int i = 0; i < 4; ++i) den += __expf(gl[i] - gm);
            const float pg = 1.f / den;
            const float va = g == 0 ? val[0] : (g == 1 ? val[1] : (g == 2 ? val[2] : val[3]));
            const float vbb = g == 0 ? val[1] : (g == 1 ? val[2] : (g == 2 ? val[3] : val[4]));
            float el[8];
#pragma unroll
            for (int i = 0; i < 8; ++i) el[i] = __shfl(i < 4 ? va : vbb, rb32 + 4 * ((4 + i) & 7)) + be[g * 8 + i];
            int i1 = 0; float v1 = el[0];
#pragma unroll
            for (int i = 1; i < 8; ++i) if (el[i] > v1) { v1 = el[i]; i1 = i; }
            int i2 = -1; float v2 = -INFINITY;
#pragma unroll
            for (int i = 0; i < 8; ++i) if (i != i1 && el[i] > v2) { v2 = el[i]; i2 = i; }
            const float t2 = __expf(v2 - v1), w1 = 1.f / (1.f + t2), w2 = t2 * w1;
            if ((lane & 31) == 0 && !dry) {
                const int ea = g * 8 + i1, eb = g * 8 + i2;
                int* PEw = (int*)(P.ws + WS_PAIRE); float* PGw = (float*)(P.ws + WS_PAIRG);
                PEw[2 * r] = ea; PEw[2 * r + 1] = eb; PGw[2 * r] = pg * w1; PGw[2 * r + 1] = pg * w2;
                const int sa = atomicAdd(&lcnt[ea], 1), sb = atomicAdd(&lcnt[eb], 1);
                const int ix = atomicAdd(&pn[0], 2);
                plist[2 * ix] = 2 * r; plist[2 * ix + 1] = (ea << 16) | sa; plist[2 * ix + 2] = 2 * r + 1; plist[2 * ix + 3] = (eb << 16) | sb;
            }
        }
    }
    if (mode == 3 && !dry) {
        __syncthreads();
        unsigned* cnt = (unsigned*)(P.ws + WS_CTL) + CW_CNT + layer * 32;
        if (tid < 32) lbase[tid] = (int)__hip_atomic_fetch_add(cnt + tid, (unsigned)lcnt[tid], __ATOMIC_RELAXED, __HIP_MEMORY_SCOPE_AGENT);
        __syncthreads();
        int* LIST = (int*)(P.ws + WS_LIST); int* PSw = (int*)(P.ws + WS_PAIRS);
        const int n = pn[0];
        for (int i = tid; i < n; i += 512) { const int pair = plist[2 * i], es = plist[2 * i + 1], e = es >> 16, slot = lbase[e] + (es & 0xffff);
            LIST[(size_t)e * NTOK + slot] = pair; PSw[pair] = slot; }
    }
    __syncthreads();
}

DEV void phase_kprep(const Params& P, unsigned char* lds, int vb, int nvb, int layer, int dry = 0) {
    const int tid = opaque_tid(), lane = tid & 63, wave = tid >> 6;
    float* red = (float*)lds;
    bf16* QKV = (bf16*)(P.ws + WS_BIG); float* KM = (float*)(P.ws + WS_KMEAN);
    const float* kn = P.in[I_CKN] + (layer >> 1) * 128;
    const float w0 = kn[2 * lane], w1 = kn[2 * lane + 1];
    for (int u = vb; u < NBATCH * 16 * 8; u += nvb) {
        const int h = u & 7, j = (u >> 3) & 15, b = u >> 7;
        float m0 = 0.f, m1 = 0.f;
        for (int i = 0; i < 32; ++i) {
            unsigned* p = (unsigned*)(QKV + ((size_t)b * SEQ + j * 256 + wave * 32 + i) * ODN + 1024 + h * 128 + 2 * lane);
            const unsigned uu = *p; float k0 = bflo(uu), k1 = bfhi(uu);
            const float rs = rsqrtf(wave_sum(k0 * k0 + k1 * k1) * (1.f / 128.f) + RMS_EPS);
            k0 *= rs * w0; k1 *= rs * w1; m0 += k0; m1 += k1;
            if (!dry) *p = pk2(k0, k1);
        }
        red[wave * 128 + 2 * lane] = m0; red[wave * 128 + 2 * lane + 1] = m1;
        __syncthreads();
        if (tid < 128) { float s = 0.f;
#pragma unroll
            for (int w = 0; w < 8; ++w) s += red[w * 128 + tid];
            if (!dry) KM[(((size_t)b * 16 + j) * 8 + h) * 128 + tid] = s * (1.f / 256.f); }
        __syncthreads();
    }
}

__global__ void __launch_bounds__(512) k_prologue(Params P) { extern __shared__ __attribute__((aligned(16))) unsigned char lds[]; phase_prologue(P, lds, blockIdx.x, gridDim.x, false); }
__global__ void __launch_bounds__(512) k_norm(Params P, int mode, int layer, const float* xsrc, float* xdst, int clayer) {
    extern __shared__ __attribute__((aligned(16))) unsigned char lds[]; phase_norm(P, lds, blockIdx.x, gridDim.x, mode, layer, xsrc, xdst, clayer); }
__global__ void __launch_bounds__(512) k_kprep(Params P, int layer) { extern __shared__ __attribute__((aligned(16))) unsigned char lds[]; phase_kprep(P, lds, blockIdx.x, gridDim.x, layer); }

namespace pg8 {
#define PG8_LAS __attribute__((address_space(3)))
typedef unsigned short bf16_t;
typedef short bf16x8 __attribute__((ext_vector_type(8)));
constexpr int BM = 256, BK = 64, HALF = 128, HTB = HALF * BK * 2  , STAGE_BYTES = 8 * HTB, NXCD = 8, WGM = 8;
__host__ __device__ __forceinline__ int lds_byte(int r, int c) { const int st = (r >> 4) * 2 + (c >> 5), rr = r & 15, cc = c & 31, ob = rr * 64 + cc * 2; return st * 1024 + (ob ^ (((ob >> 9) & 1) << 5)); }
__host__ __device__ __forceinline__ void stage_rc(int b, int& R, int& C) { const int st = b / 1024, sb = b % 1024, swz = sb ^ (((sb >> 9) & 1) << 5); R = (st >> 1) * 16 + swz / 64; C = (st & 1) * 32 + (swz % 64) / 2; }
__host__ __device__ __forceinline__ int perm32(int rho) { const int n = rho >> 4, i = rho & 15; return 8 * (i >> 2) + 4 * n + (i & 3); }

struct Unit { int pm, pn, bsel, aux; };
struct Gemm { const bf16_t* A; const bf16_t* Bt; int K; size_t bstride; };

struct StaticOrder {
    static constexpr bool GATHER = false;
    PG8_LAS int* tokl; int nM, nN, nwg, G, c;
    __device__ void init(int M, int N, int G_, int c_) { nM = M / BM; nN = N / BM; nwg = nM * nN; G = G_; c = c_; }
    __device__ bool next(int i, Unit& u) const {
        const long L = (long)i * G + c; if (L >= nwg) return false;
        int wgid = (int)L; { const int q = nwg / NXCD, r = nwg % NXCD, xcd = wgid % NXCD, off = wgid / NXCD; wgid = (xcd < r ? xcd * (q + 1) : r * (q + 1) + (xcd - r) * q) + off; }
        const int nig = WGM * nN, gid = wgid / nig, fm = gid * WGM, gsz = (nM - fm) < WGM ? (nM - fm) : WGM;
        u.pm = fm + ((wgid % nig) % gsz); u.pn = (wgid % nig) / gsz; u.bsel = 0; u.aux = 0; return true;
    }
    __device__ __forceinline__ int src_row(const Unit&, int) const { return 0; }
};
template <bool GATHER_> struct MoeOrder {
    static constexpr bool GATHER = GATHER_;
    const PG8_LAS int* tp; const PG8_LAS unsigned* cnt; const int* list; PG8_LAS int* tokl; int nN, G, c;
    __device__ bool next(int i, Unit& u) const {
        const int L = i * G + c; const int rt = L / nN; if (rt >= tp[NEXP]) return false;
        int e = 0;
#pragma unroll 1
        for (int k = 1; k < NEXP; ++k) e = (rt >= tp[k]) ? k : e;
        u.pm = rt; u.pn = L - rt * nN; u.bsel = e; u.aux = rt - tp[e]; return true;
    }
    __device__ __forceinline__ int src_row(const Unit& u, int r) const { const int s = u.aux * BM + r; return s < (int)cnt[u.bsel] ? (list[(size_t)u.bsel * NTOK + s] >> 1) : 0; }
};

__device__ __forceinline__ unsigned cvt_pk_bf16(float lo, float hi) { unsigned r; asm volatile("v_cvt_pk_bf16_f32 %0, %1, %2" : "=v"(r) : "v"(lo), "v"(hi)); return r; }
struct EpiBf16 {
    static constexpr bool PERM = true;
    bf16_t* O; int ldc;
    __device__ __forceinline__ void operator()(const f32x4 (&acc)[2][2][4][2], const Unit& u, int wr, int wc, int fr, int fq) const {
        const int row0 = u.pm * BM + wr * 64 + fr, col0 = u.pn * BM + wc * 32 + 8 * fq;
#pragma unroll
        for (int ai = 0; ai < 2; ++ai)
#pragma unroll
            for (int m = 0; m < 4; ++m) { bf16_t* rowp = O + (size_t)(row0 + ai * HALF + m * 16) * ldc + col0;
#pragma unroll
                for (int bj = 0; bj < 2; ++bj) { const f32x4 v0 = acc[ai][bj][m][0], v1 = acc[ai][bj][m][1];
                    u32x4 w; w.x = cvt_pk_bf16(v0[0], v0[1]); w.y = cvt_pk_bf16(v0[2], v0[3]); w.z = cvt_pk_bf16(v1[0], v1[1]); w.w = cvt_pk_bf16(v1[2], v1[3]);
                    *(u32x4*)(rowp + bj * HALF) = w; } }
    }
};
struct EpiResid {
    static constexpr bool PERM = false;
    const float* xin; float* xout; const float* gate; int dry;
    __device__ __forceinline__ void operator()(const f32x4 (&acc)[2][2][4][2], const Unit& u, int wr, int wc, int fr, int fq) const {
        const int row0 = u.pm * BM + wr * 64 + fr, col0 = u.pn * BM + wc * 32 + 4 * fq;
        const float* gr = gate + (size_t)((u.pm * BM) >> 12) * (6 * DM) + col0;
        f32x4 gv[2][2];
#pragma unroll
        for (int bj = 0; bj < 2; ++bj)
#pragma unroll
            for (int n = 0; n < 2; ++n) gv[bj][n] = *(const f32x4*)(gr + bj * HALF + n * 16);
#pragma unroll
        for (int ai = 0; ai < 2; ++ai)
#pragma unroll
            for (int m = 0; m < 4; ++m) { const size_t off = (size_t)(row0 + ai * HALF + m * 16) * DM + col0;
#pragma unroll
                for (int bj = 0; bj < 2; ++bj)
#pragma unroll
                    for (int n = 0; n < 2; ++n) { const f32x4 xi = *(const f32x4*)(xin + off + bj * HALF + n * 16); const f32x4 ov = xi + gv[bj][n] * acc[ai][bj][m][n]; if (!dry) *(f32x4*)(xout + off + bj * HALF + n * 16) = ov; } }
    }
};
struct EpiSiluMul {
    static constexpr bool PERM = true;
    bf16_t* O;
    __device__ __forceinline__ void operator()(const f32x4 (&acc)[2][2][4][2], const Unit& u, int wr, int wc, int fr, int fq) const {
        const int row0 = u.pm * BM + wr * 64 + fr, col0 = u.pn * HALF + wc * 32 + 8 * fq;
#pragma unroll
        for (int ai = 0; ai < 2; ++ai)
#pragma unroll
            for (int m = 0; m < 4; ++m) { bf16_t* rowp = O + (size_t)(row0 + ai * HALF + m * 16) * MOEH + col0;
                float o[8];
#pragma unroll
                for (int n = 0; n < 2; ++n)
#pragma unroll
                    for (int j = 0; j < 4; ++j) { const float a = acc[ai][0][m][n][j], b = acc[ai][1][m][n][j]; o[n * 4 + j] = a * __builtin_amdgcn_rcpf(1.f + __expf(-a)) * b; }
                u32x4 w; w.x = cvt_pk_bf16(o[0], o[1]); w.y = cvt_pk_bf16(o[2], o[3]); w.z = cvt_pk_bf16(o[4], o[5]); w.w = cvt_pk_bf16(o[6], o[7]);
                *(u32x4*)rowp = w; }
    }
};

template <class Epi, class Sched>
__device__ __forceinline__ void gemm_phase(PG8_LAS unsigned char* lds, const Gemm g, const Sched& S, const Epi& E) {
    constexpr bool GA = Sched::GATHER;
    const int tid = opaque_tid(), wid = __builtin_amdgcn_readfirstlane(tid >> 6), lane = tid & 63, wr = wid >> 2, wc = wid & 3, fr = lane & 15, fq = lane >> 4;
    const int K = g.K, nt = K / BK;
    const size_t kstep = (size_t)(BK * 2);
    const size_t hstep = (size_t)HALF * K * 2;
    const size_t tstep = 2 * hstep;
    unsigned voffB[2]; int RA[2], CA[2];
#pragma unroll
    for (int i = 0; i < 2; ++i) { int R, C; stage_rc(tid * 16 + i * 8192, R, C); const int Rb = Epi::PERM ? ((R & ~31) + perm32(R & 31)) : R;
        RA[i] = R; CA[i] = C; voffB[i] = (unsigned)(Rb * K + C) * 2u; }
    const unsigned ldsw = (unsigned)wid * 1024u;
    const int aoff = lds_byte(wr * 64 + fr, fq * 8), boff = lds_byte(wc * 32 + fr, fq * 8);
#define PG8_SA(b, h) (((b) * 2 + (h)) * HTB)
#define PG8_SB(b, h) ((4 + (b) * 2 + (h)) * HTB)
#define PG8_STAGE2(bufoff, gbase, o0, o1) do { \
        __builtin_amdgcn_global_load_lds((const unsigned*)((const char*)(gbase) + (o0)), (PG8_LAS unsigned*)(lds + (bufoff) + ldsw), 16, 0, 0); \
        __builtin_amdgcn_global_load_lds((const unsigned*)((const char*)(gbase) + (o1)), (PG8_LAS unsigned*)(lds + (bufoff) + ldsw + 8192), 16, 0, 0); } while (0)
#define PG8_STAGEB(bufoff, gbase) PG8_STAGE2(bufoff, gbase, voffB[0], voffB[1])
#define PG8_LDA(dst, b, h) do { _Pragma("unroll") for (int m = 0; m < 4; ++m) _Pragma("unroll") for (int k = 0; k < 2; ++k) dst[m][k] = *(const PG8_LAS bf16x8*)(lds + PG8_SA(b, h) + aoff + m * 2048 + k * 1024); } while (0)
#define PG8_LDB(dst, b, h) do { _Pragma("unroll") for (int n = 0; n < 2; ++n) _Pragma("unroll") for (int k = 0; k < 2; ++k) dst[n][k] = *(const PG8_LAS bf16x8*)(lds + PG8_SB(b, h) + boff + n * 2048 + k * 1024); } while (0)
#define PG8_MMA(ai, bj, At, Bt) do { __builtin_amdgcn_s_setprio(1); _Pragma("unroll") for (int m = 0; m < 4; ++m) _Pragma("unroll") for (int n = 0; n < 2; ++n) _Pragma("unroll") for (int k = 0; k < 2; ++k) \
        acc[ai][bj][m][n] = __builtin_amdgcn_mfma_f32_16x16x32_bf16(Bt[n][k], At[m][k], acc[ai][bj][m][n], 0, 0, 0); __builtin_amdgcn_s_setprio(0); } while (0)
#define PG8_WAIT_V(n) asm volatile("s_waitcnt vmcnt(" #n ")" ::: "memory")
#define PG8_WAIT_L(n) asm volatile("s_waitcnt lgkmcnt(" #n ")" ::: "memory")
#define PG8_BAR __builtin_amdgcn_s_barrier()
#define PG8_SCHED __builtin_amdgcn_sched_barrier(0)
    Unit cur, nxt; int ui = 0;
    if (!S.next(0, cur)) return;
    f32x4 acc[2][2][4][2];
#pragma unroll
    for (int a = 0; a < 2; ++a)
#pragma unroll
        for (int b = 0; b < 2; ++b)
#pragma unroll
            for (int m = 0; m < 4; ++m)
#pragma unroll
                for (int n = 0; n < 2; ++n) acc[a][b][m][n] = (f32x4){0.f, 0.f, 0.f, 0.f};
    bf16x8 At[4][2], B0[2][2], B1[2][2];
    unsigned vA[2][2];
    if constexpr (GA) {
        if (tid < BM) S.tokl[tid] = S.src_row(cur, tid);
        asm volatile("s_waitcnt vmcnt(0) lgkmcnt(0)" ::: "memory"); __builtin_amdgcn_s_barrier(); asm volatile("" ::: "memory");
#pragma unroll
        for (int h = 0; h < 2; ++h)
#pragma unroll
            for (int i = 0; i < 2; ++i) vA[h][i] = (unsigned)(S.tokl[h * HALF + RA[i]] * K + CA[i]) * 2u;
    } else {
#pragma unroll
        for (int h = 0; h < 2; ++h)
#pragma unroll
            for (int i = 0; i < 2; ++i) vA[h][i] = (unsigned)(RA[i] * K + CA[i]) * 2u;
    }
    const size_t ah = GA ? (size_t)0 : hstep;
    const char* cA = GA ? (const char*)g.A : (const char*)g.A + (size_t)cur.pm * tstep;
    const char* cB = (const char*)(g.Bt + (size_t)cur.bsel * g.bstride) + (size_t)cur.pn * tstep;
    PG8_STAGEB(PG8_SB(0, 0), cB); PG8_STAGEB(PG8_SB(0, 1), cB + hstep); PG8_STAGE2(PG8_SA(0, 0), cA, vA[0][0], vA[0][1]); PG8_STAGE2(PG8_SA(0, 1), cA + ah, vA[1][0], vA[1][1]);
    if (wr == 1) PG8_BAR;
    PG8_WAIT_V(2); PG8_BAR;
    PG8_STAGEB(PG8_SB(1, 0), cB + kstep); PG8_STAGE2(PG8_SA(1, 0), cA + kstep, vA[0][0], vA[0][1]); PG8_STAGEB(PG8_SB(1, 1), cB + hstep + kstep);
    PG8_WAIT_V(6); PG8_BAR;
    for (;;) {
        const bool has_next = S.next(ui + 1, nxt);
        if constexpr (GA) { if (has_next && tid < BM) S.tokl[tid] = S.src_row(nxt, tid); }
        const char* nA = GA ? cA : (has_next ? (const char*)g.A + (size_t)nxt.pm * tstep : cA);
        const char* nB = has_next ? (const char*)(g.Bt + (size_t)nxt.bsel * g.bstride) + (size_t)nxt.pn * tstep : cB;
        for (int t = 0; t < nt; t += 2) {
            const bool last = (t == nt - 2);
            const char* a1 = cA + (size_t)(t + 1) * kstep;
            const char* a2 = last ? nA : cA + (size_t)(t + 2) * kstep; const char* b2 = last ? nB : cB + (size_t)(t + 2) * kstep;
            const char* a3 = a2 + kstep; const char* b3 = b2 + kstep;
            PG8_LDB(B0, 0, 0); PG8_LDB(B1, 0, 1); PG8_SCHED; PG8_LDA(At, 0, 0); PG8_STAGE2(PG8_SA(1, 1), a1 + ah, vA[1][0], vA[1][1]);
            if constexpr (GA) { if (last) {
#pragma unroll
                for (int h = 0; h < 2; ++h)
#pragma unroll
                    for (int i = 0; i < 2; ++i) vA[h][i] = (unsigned)(S.tokl[h * HALF + RA[i]] * K + CA[i]) * 2u; } }
            PG8_WAIT_V(8); PG8_WAIT_L(0); PG8_BAR; PG8_MMA(0, 0, At, B0); PG8_MMA(0, 1, At, B1); PG8_BAR; PG8_SCHED;
            PG8_LDA(At, 0, 1); PG8_STAGEB(PG8_SB(0, 0), b2); PG8_STAGEB(PG8_SB(0, 1), b2 + hstep); PG8_STAGE2(PG8_SA(0, 0), a2, vA[0][0], vA[0][1]);
            PG8_WAIT_V(8); PG8_WAIT_L(0); PG8_BAR; PG8_MMA(1, 0, At, B0); PG8_MMA(1, 1, At, B1); PG8_BAR; PG8_SCHED;
            PG8_LDB(B0, 1, 0); PG8_LDB(B1, 1, 1); PG8_SCHED; PG8_LDA(At, 1, 0); PG8_STAGE2(PG8_SA(0, 1), a2 + ah, vA[1][0], vA[1][1]);
            PG8_WAIT_V(8); PG8_WAIT_L(0); PG8_BAR; PG8_MMA(0, 0, At, B0); PG8_MMA(0, 1, At, B1); PG8_BAR; PG8_SCHED;
            PG8_LDA(At, 1, 1); PG8_STAGEB(PG8_SB(1, 0), b3); PG8_STAGEB(PG8_SB(1, 1), b3 + hstep); PG8_STAGE2(PG8_SA(1, 0), a3, vA[0][0], vA[0][1]);
            PG8_WAIT_V(8); PG8_WAIT_L(0); PG8_BAR; PG8_MMA(1, 0, At, B0); PG8_MMA(1, 1, At, B1); PG8_BAR; PG8_SCHED;
        }
        if (wr == 0) PG8_BAR;
        E(acc, cur, wr, wc, fr, fq);
        if (!has_next) break;
#pragma unroll
        for (int a = 0; a < 2; ++a)
#pragma unroll
            for (int b = 0; b < 2; ++b)
#pragma unroll
                for (int m = 0; m < 4; ++m)
#pragma unroll
                    for (int n = 0; n < 2; ++n) acc[a][b][m][n] = (f32x4){0.f, 0.f, 0.f, 0.f};
        cur = nxt; cA = nA; cB = nB; ++ui;
        if (wr == 1) PG8_BAR;
    }
    PG8_WAIT_V(0);
    PG8_BAR;
#undef PG8_SA
#undef PG8_SB
#undef PG8_STAGE2
#undef PG8_STAGEB
#undef PG8_LDA
#undef PG8_LDB
#undef PG8_MMA
#undef PG8_WAIT_V
#undef PG8_WAIT_L
#undef PG8_BAR
#undef PG8_SCHED
}
}

namespace att {
typedef short bf16x8 __attribute__((ext_vector_type(8)));
typedef short s16x4 __attribute__((ext_vector_type(4)));
typedef float f32x16 __attribute__((ext_vector_type(16)));
constexpr int KVBLK = 64, SHM_K = 16384, SHM_V = 16384;
constexpr float LOG2E = 1.4426950408889634f;
#define KSWZ(row, colB) ((row) * 256 + ((colB) ^ (((row) & 7) << 4)))
#define SBAR() __builtin_amdgcn_sched_barrier(0)
DEV int v_st(int k, int c) { const int kk = (k & ~0xC) | ((k & 4) << 1) | ((k & 8) >> 1); return ((kk >> 3) * 4 + (c >> 5)) * 512 + ((kk & 7) * 32 + (c & 31)) * 2; }
DEV int v_rd_base(int lane) { return ((lane & 3) << 3) | (((lane >> 2) & 3) << 6) | (((lane >> 4) & 1) << 5) | (((lane >> 5) & 1) << 8); }
constexpr int v_rd_off(int d0, int ks, int half) { return d0 * 512 + ks * 4096 + half * 2048; }
DEV int crow(int r, int hi) { return (r & 3) + 8 * (r >> 2) + 4 * hi; }
DEV unsigned cvtpk(float lo, float hi) { unsigned r; asm volatile("v_cvt_pk_bf16_f32 %0, %1, %2" : "=v"(r) : "v"(lo), "v"(hi)); return r; }
template <int ND>
DEV void qkt(f32x16& p0, f32x16& p1, const char* kbase, int r32, int hi, const bf16x8* qr) {
    p0 = f32x16{}; p1 = f32x16{};
    const char* kb[4];
#pragma unroll
    for (int dd = 0; dd < 4; ++dd) kb[dd] = kbase + KSWZ(r32, (dd * 16 + hi * 8) * 2);
#pragma unroll
    for (int d0 = 0; d0 < ND; ++d0) { const char* a = kb[d0 & 3] + (d0 >> 2) * 128;
        bf16x8 b0 = *reinterpret_cast<const bf16x8*>(a);
        bf16x8 b1 = *reinterpret_cast<const bf16x8*>(a + 32 * 256);
        p0 = __builtin_amdgcn_mfma_f32_32x32x16_bf16(b0, qr[d0], p0, 0, 0, 0);
        p1 = __builtin_amdgcn_mfma_f32_32x32x16_bf16(b1, qr[d0], p1, 0, 0, 0); }
}
DEV void qkt_half_acc(f32x16& p0, const char* kbase, int r32, int hi, const bf16x8* qr) {
    const char* kb[4];
#pragma unroll
    for (int dd = 0; dd < 4; ++dd) kb[dd] = kbase + KSWZ(r32, (dd * 16 + hi * 8) * 2);
#pragma unroll
    for (int d0 = 0; d0 < 8; ++d0) { const char* a = kb[d0 & 3] + (d0 >> 2) * 128;
        bf16x8 b0 = *reinterpret_cast<const bf16x8*>(a);
        p0 = __builtin_amdgcn_mfma_f32_32x32x16_bf16(b0, qr[d0], p0, 0, 0, 0); }
}
template <int VB, int ND0 = 4>
DEV void pv_tile(f32x16* o, int vb0, bf16x8 pa0, bf16x8 pa1, bf16x8 pa2, bf16x8 pa3) {
#define TRRD(dst, off) asm volatile("ds_read_b64_tr_b16 %0, %1 offset:%2" : "=&v"(dst) : "v"(vb0), "i"(off) : "memory")
#define PV_D0(d0) do { s16x4 l0, l1, l2, l3, h0, h1, h2, h3; constexpr int b_ = VB * SHM_V + v_rd_off(d0, 0, 0);   \
        TRRD(l0, b_); TRRD(h0, b_ + 2048); TRRD(l1, b_ + 4096); TRRD(h1, b_ + 6144); TRRD(l2, b_ + 8192); TRRD(h2, b_ + 10240); TRRD(l3, b_ + 12288); TRRD(h3, b_ + 14336); \
        asm volatile("s_waitcnt lgkmcnt(0)" ::: "memory"); SBAR();   \
        o[d0] = __builtin_amdgcn_mfma_f32_32x32x16_bf16(pa0, (bf16x8){l0[0], l0[1], l0[2], l0[3], h0[0], h0[1], h0[2], h0[3]}, o[d0], 0, 0, 0);   \
        o[d0] = __builtin_amdgcn_mfma_f32_32x32x16_bf16(pa1, (bf16x8){l1[0], l1[1], l1[2], l1[3], h1[0], h1[1], h1[2], h1[3]}, o[d0], 0, 0, 0);   \
        o[d0] = __builtin_amdgcn_mfma_f32_32x32x16_bf16(pa2, (bf16x8){l2[0], l2[1], l2[2], l2[3], h2[0], h2[1], h2[2], h2[3]}, o[d0], 0, 0, 0);   \
        o[d0] = __builtin_amdgcn_mfma_f32_32x32x16_bf16(pa3, (bf16x8){l3[0], l3[1], l3[2], l3[3], h3[0], h3[1], h3[2], h3[3]}, o[d0], 0, 0, 0); } while (0)
    PV_D0(0); if constexpr (ND0 > 1) PV_D0(1); if constexpr (ND0 > 2) { PV_D0(2); PV_D0(3); }
#undef PV_D0
#undef TRRD
}
DEV void pack_p(const f32x16& p0, const f32x16& p1, bf16x8& pa0, bf16x8& pa1, bf16x8& pa2, bf16x8& pa3) {
#define PK4(P, B_, OUT) do { unsigned a0 = cvtpk(P[B_+0], P[B_+1]), a1 = cvtpk(P[B_+2], P[B_+3]);                          \
        unsigned b0 = cvtpk(P[B_+4], P[B_+5]), b1 = cvtpk(P[B_+6], P[B_+7]);                                             \
        auto r0 = __builtin_amdgcn_permlane32_swap(a0, b0, false, false); auto r1 = __builtin_amdgcn_permlane32_swap(a1, b1, false, false); \
        u32x4 w = {r0[0], r1[0], r0[1], r1[1]}; OUT = *reinterpret_cast<bf16x8*>(&w); } while (0)
    PK4(p0, 0, pa0); PK4(p0, 8, pa1); PK4(p1, 0, pa2); PK4(p1, 8, pa3);
#undef PK4
}
DEV float half_max(float v) { auto rr = __builtin_amdgcn_permlane32_swap(__float_as_uint(v), __float_as_uint(v), false, false); return fmaxf(__uint_as_float(rr[0]), __uint_as_float(rr[1])); }
DEV float half_sum(float v) { auto rr = __builtin_amdgcn_permlane32_swap(__float_as_uint(v), __float_as_uint(v), false, false); return __uint_as_float(rr[0]) + __uint_as_float(rr[1]); }

constexpr int L_V = 0, L_K = 2 * SHM_V, L_WS = L_K + 2 * SHM_K, L_BT = L_WS + 8 * 256, L_QW = L_BT + 512, L_END = L_QW + 512;

DEV void moba_unit(const Params& P, char* lds, int layer, int b, int h, int qb) {
    const int tid = opaque_tid(), wid = __builtin_amdgcn_readfirstlane(tid >> 6), lane = tid & 63, r32 = lane & 31, hi = lane >> 5;
    const bf16* QKV = (const bf16*)(P.ws + WS_BIG);
    char* V_lds = lds + L_V; char* K_lds = lds + L_K;
    float* wsf = (float*)(lds + L_WS) + wid * 64; float* li_l = wsf; float* al_l = wsf + 32;
    float* bt = (float*)(lds + L_BT); const float* qw = (const float*)(lds + L_QW);
    const int sr = tid >> 4, sc = (tid & 15) * 8, vst0 = v_st(sr, sc), vst1 = v_st(32 + sr, sc), kws = KSWZ(sr, sc * 2);
    const int vb0 = (int)(uintptr_t)V_lds + v_rd_base(lane);
    const size_t tok0 = (size_t)b * SEQ;
    if (tid < 128) bt[tid] = ((const float*)(P.ws + WS_BT))[h * 128 + tid];
    if (tid < 256) { const int row = tid >> 4, ch = tid & 15; const float* km = (const float*)(P.ws + WS_KMEAN) + ((((size_t)b * 16 + row) * 8 + h) * 128 + ch * 8);
        const f32x4 a = *(const f32x4*)km, c = *(const f32x4*)(km + 4);
        float x[8] = {a.x, a.y, a.z, a.w, c.x, c.y, c.z, c.w}; unsigned hw[4], lw[4];
#pragma unroll
        for (int i = 0; i < 4; ++i) { const unsigned h0 = f2bf(x[2 * i]), h1 = f2bf(x[2 * i + 1]); hw[i] = h0 | (h1 << 16);
            lw[i] = pk2(x[2 * i] - __uint_as_float(h0 << 16), x[2 * i + 1] - __uint_as_float(h1 << 16)); }
        *(u32x4*)(K_lds + KSWZ(row, ch * 16)) = (u32x4){hw[0], hw[1], hw[2], hw[3]};
        *(u32x4*)(K_lds + SHM_K + KSWZ(row, ch * 16)) = (u32x4){lw[0], lw[1], lw[2], lw[3]}; }
    bf16x8 qr[8];
    { const bf16* qp = QKV + (tok0 + qb * 256 + wid * 32 + r32) * ODN + h * 128 + hi * 8;
      u32x4 raw[8]; float ss = 0.f;
#pragma unroll
      for (int d0 = 0; d0 < 8; ++d0) { raw[d0] = *(const u32x4*)(qp + d0 * 16);
#pragma unroll
          for (int i = 0; i < 4; ++i) { const float lo = bflo(raw[d0][i]), hh = bfhi(raw[d0][i]); ss += lo * lo + hh * hh; } }
      ss = half_sum(ss);
      const float rs = rsqrtf(ss * (1.f / 128.f) + RMS_EPS);
      __syncthreads();
#pragma unroll
      for (int d0 = 0; d0 < 8; ++d0) { const f32x4 w0 = *(const f32x4*)(qw + d0 * 16 + hi * 8), w1 = *(const f32x4*)(qw + d0 * 16 + hi * 8 + 4);
          u32x4 o; o.x = cvtpk(bflo(raw[d0].x) * rs * w0.x, bfhi(raw[d0].x) * rs * w0.y); o.y = cvtpk(bflo(raw[d0].y) * rs * w0.z, bfhi(raw[d0].y) * rs * w0.w);
          o.z = cvtpk(bflo(raw[d0].z) * rs * w1.x, bfhi(raw[d0].z) * rs * w1.y); o.w = cvtpk(bflo(raw[d0].w) * rs * w1.z, bfhi(raw[d0].w) * rs * w1.w);
          qr[d0] = *reinterpret_cast<bf16x8*>(&o); } }
    unsigned selmask = 0u;
    { f32x16 ps = f32x16{};
      qkt_half_acc(ps, K_lds, r32, hi, qr); qkt_half_acc(ps, K_lds + SHM_K, r32, hi, qr);
      float scv[16];
#pragma unroll
      for (int r = 0; r < 8; ++r) { const float mine = ps[r], oth = __shfl_xor(mine, 32); const int jm = (r & 3) + 8 * (r >> 2);
          scv[jm + 4 * 0] = hi ? oth : mine; scv[jm + 4] = hi ? mine : oth; }
#pragma unroll
      for (int j = 0; j < 16; ++j) if (j >= qb) scv[j] = -INFINITY;
#pragma unroll
      for (int n = 0; n < 3; ++n) { float mx = -INFINITY; int ix = -1;
#pragma unroll
          for (int j = 0; j < 16; ++j) if (scv[j] > mx) { mx = scv[j]; ix = j; }
#pragma unroll
          for (int j = 0; j < 16; ++j) if (j == ix) scv[j] = -INFINITY;
          if (ix >= 0) selmask |= 1u << ix; } }
    __syncthreads();
    const int NT = 4 * (qb + 1);
    const int qrow = wid * 32 + r32;
    const bf16* Kg = QKV + tok0 * ODN + 1024 + h * 128 + sc; const bf16* Vg = Kg + 1024;
    bf16x8 st_k0, st_k1, st_v0, st_v1;
#define SLOAD(t) do { const size_t k0_ = (size_t)(t) * 64; st_k0 = *(const bf16x8*)(Kg + (k0_ + sr) * ODN); st_k1 = *(const bf16x8*)(Kg + (k0_ + 32 + sr) * ODN); \
                      st_v0 = *(const bf16x8*)(Vg + (k0_ + sr) * ODN); st_v1 = *(const bf16x8*)(Vg + (k0_ + 32 + sr) * ODN); } while (0)
#define SWRITE(bf) do { *(bf16x8*)(K_lds + (bf) * SHM_K + kws) = st_k0; *(bf16x8*)(K_lds + (bf) * SHM_K + kws + 32 * 256) = st_k1; \
                        *(bf16x8*)(V_lds + (bf) * SHM_V + vst0) = st_v0; *(bf16x8*)(V_lds + (bf) * SHM_V + vst1) = st_v1; } while (0)
    float m_reg = -1e30f, l_reg = 0.f; f32x16 o[4] = {};
    const float cfar = bt[127];
    SLOAD(0); SWRITE(0); __syncthreads();
#define TILE_STEP(t, BUF) do { \
        if ((t) + 1 < NT) SLOAD((t) + 1); \
        const int jb_ = (t) >> 2, tt_ = (t) & 3; const bool own_ = (jb_ == qb); \
        const bool need_ = own_ ? (tt_ * 64 <= wid * 32 + 31) : (__ballot((selmask >> jb_) & 1u) != 0ull);     \
        if (need_) { \
            f32x16 p0, p1; qkt<8>(p0, p1, K_lds + (BUF) * SHM_K, r32, hi, qr); \
            const int dq_ = (qb - jb_) * 256 + qrow - tt_ * 64 - 4 * hi;                   \
            const bool far_ = ((qb - jb_) * 256 + wid * 32 - tt_ * 64 - 63) >= 127;        \
            if (far_) { _Pragma("unroll") for (int r = 0; r < 16; ++r) { p0[r] = fmaf(p0[r], 0.08838834764831845f, cfar); p1[r] = fmaf(p1[r], 0.08838834764831845f, cfar); } } \
            else { _Pragma("unroll") for (int r = 0; r < 16; ++r) { const int c_ = (r & 3) + 8 * (r >> 2); const int d0_ = dq_ - c_, d1_ = d0_ - 32; \
                       const float b0_ = bt[d0_ < 0 ? 0 : (d0_ > 127 ? 127 : d0_)], b1_ = bt[d1_ < 0 ? 0 : (d1_ > 127 ? 127 : d1_)]; \
                       p0[r] = d0_ < 0 ? -INFINITY : fmaf(p0[r], 0.08838834764831845f, b0_); p1[r] = d1_ < 0 ? -INFINITY : fmaf(p1[r], 0.08838834764831845f, b1_); } } \
            if (!own_ && !((selmask >> jb_) & 1u)) { _Pragma("unroll") for (int r = 0; r < 16; ++r) { p0[r] = -INFINITY; p1[r] = -INFINITY; } } \
            float pmax_ = p0[0]; _Pragma("unroll") for (int r = 1; r < 16; ++r) pmax_ = fmaxf(pmax_, p0[r]); _Pragma("unroll") for (int r = 0; r < 16; ++r) pmax_ = fmaxf(pmax_, p1[r]); \
            pmax_ = half_max(pmax_); \
            const float mn_ = fmaxf(m_reg, pmax_); const float alpha_ = __builtin_amdgcn_exp2f((m_reg - mn_) * LOG2E); m_reg = mn_; \
            const float mnl_ = -mn_ * LOG2E; float psum_ = 0.f; \
            _Pragma("unroll") for (int r = 0; r < 16; ++r) { p0[r] = __builtin_amdgcn_exp2f(fmaf(p0[r], LOG2E, mnl_)); p1[r] = __builtin_amdgcn_exp2f(fmaf(p1[r], LOG2E, mnl_)); psum_ += p0[r] + p1[r]; } \
            psum_ = half_sum(psum_); l_reg = l_reg * alpha_ + psum_; \
            bf16x8 pa0, pa1, pa2, pa3; pack_p(p0, p1, pa0, pa1, pa2, pa3); \
            if (__any(alpha_ < 1.f)) { if (hi == 0) al_l[r32] = alpha_; asm volatile("s_waitcnt lgkmcnt(0)" ::: "memory"); \
                _Pragma("unroll") for (int d_ = 0; d_ < 4; ++d_) _Pragma("unroll") for (int r = 0; r < 16; ++r) o[d_][r] *= al_l[crow(r, hi)]; } \
            pv_tile<BUF>(o, vb0, pa0, pa1, pa2, pa3); \
        } \
        if ((t) + 1 < NT) { SWRITE((BUF) ^ 1); } \
        __syncthreads(); } while (0)
    for (int t = 0; t < NT; t += 2) { TILE_STEP(t, 0); TILE_STEP(t + 1, 1); }
#undef TILE_STEP
#undef SLOAD
#undef SWRITE
    if (hi == 0) li_l[r32] = l_reg; asm volatile("s_waitcnt lgkmcnt(0)" ::: "memory");
    bf16* Ow = (bf16*)(P.ws + WS_MIX) + (tok0 + qb * 256 + wid * 32) * DM + h * 128;
#pragma unroll
    for (int r = 0; r < 16; ++r) { const int orow = crow(r, hi); const float rl = __builtin_amdgcn_rcpf(li_l[orow]);
#pragma unroll
        for (int d0 = 0; d0 < 4; ++d0) { const float v = o[d0][r] * rl; const float vn = __shfl_xor(v, 1);
            if ((r32 & 1) == 0) *(unsigned*)(Ow + (size_t)orow * DM + d0 * 32 + r32) = cvtpk(v, vn); } }
    __syncthreads();
}
DEV void phase_moba(const Params& P, unsigned char* lds, int vb, int nvb, int layer) {
    { const int tid = opaque_tid(); if (tid < 128) ((float*)(lds + L_QW))[tid] = P.in[I_CQN][(layer >> 1) * 128 + tid]; }
    __syncthreads();
    for (int it = vb; it < NBATCH * 8 * 8; it += nvb) {
        const int pr = it & 7, h = (it >> 3) & 7, b = it >> 6;
        moba_unit(P, (char*)lds, layer, b, h, pr);
        moba_unit(P, (char*)lds, layer, b, h, 15 - pr);
    }
}

constexpr int S_V = 0, S_K = 65536, S_WS = 131072, S_BT = S_WS + 2048, S_QW = S_BT + 2048, S_KW = S_QW + 256;
DEV void swa_unit(const Params& P, char* lds, int layer, int b, int kvh, int n) {
    const int tid = opaque_tid(), wid = __builtin_amdgcn_readfirstlane(tid >> 6), lane = tid & 63, r32 = lane & 31, hi = lane >> 5;
    const int g = wid >> 1, h = kvh * 4 + g, jl = layer >> 1;
    const bf16* QKV = (const bf16*)(P.ws + WS_BIG);
    char* V_lds = lds + S_V; char* K_lds = lds + S_K;
    float* wsf = (float*)(lds + S_WS) + wid * 64; float* li_l = wsf; float* al_l = wsf + 32;
    const float* bt = (const float*)(lds + S_BT) + g * 128; const float* qw = (const float*)(lds + S_QW); const float* kw = (const float*)(lds + S_KW);
    ((float*)(lds + S_BT))[tid] = ((const float*)(P.ws + WS_BT))[(kvh * 4 + (tid >> 7)) * 128 + (tid & 127)];
#pragma unroll
    for (int i = 0; i < 4; ++i) { const int idx = tid + 512 * i, key = idx >> 3, ch = idx & 7, s = (n - 1) * 128 + key;
        u32x4 kr = (u32x4){0u, 0u, 0u, 0u}, vr = kr;
        if (s >= 0) { const bf16* rp = QKV + ((size_t)b * SEQ + s) * EVN; kr = *(const u32x4*)(rp + 512 + kvh * 64 + ch * 8); vr = *(const u32x4*)(rp + 640 + kvh * 64 + ch * 8); }
        float kf[8] = {bflo(kr.x), bfhi(kr.x), bflo(kr.y), bfhi(kr.y), bflo(kr.z), bfhi(kr.z), bflo(kr.w), bfhi(kr.w)};
        float ss = 0.f;
#pragma unroll
        for (int e = 0; e < 8; ++e) ss += kf[e] * kf[e];
        ss += __shfl_xor(ss, 1); ss += __shfl_xor(ss, 2); ss += __shfl_xor(ss, 4);
        const float rs = rsqrtf(ss * (1.f / 64.f) + RMS_EPS);
        const f32x4 w0 = *(const f32x4*)(kw + ch * 8), w1 = *(const f32x4*)(kw + ch * 8 + 4);
        u32x4 ko; ko.x = cvtpk(kf[0] * rs * w0.x, kf[1] * rs * w0.y); ko.y = cvtpk(kf[2] * rs * w0.z, kf[3] * rs * w0.w); ko.z = cvtpk(kf[4] * rs * w1.x, kf[5] * rs * w1.y); ko.w = cvtpk(kf[6] * rs * w1.z, kf[7] * rs * w1.w);
        *(u32x4*)(K_lds + (key >> 6) * SHM_K + KSWZ(key & 63, ch * 16)) = ko;
        *(u32x4*)(V_lds + (key >> 6) * SHM_V + v_st(key & 63, ch * 8)) = vr; }
    __syncthreads();
    const int vb0 = (int)(uintptr_t)V_lds + v_rd_base(lane);
    const float sink = P.in[I_ASINK][jl * 8 + h];
#pragma unroll 1
    for (int gi = 0; gi < 2; ++gi) {
        const int q0 = (wid & 1) * 64 + gi * 32; const size_t tok = (size_t)b * SEQ + n * 128 + q0 + r32;
        bf16x8 qr[4];
        { const bf16* qp = QKV + tok * EVN + h * 64 + hi * 8; u32x4 raw[4]; float ss = 0.f;
#pragma unroll
          for (int d0 = 0; d0 < 4; ++d0) { raw[d0] = *(const u32x4*)(qp + d0 * 16);
#pragma unroll
              for (int i = 0; i < 4; ++i) { const float lo = bflo(raw[d0][i]), hh = bfhi(raw[d0][i]); ss += lo * lo + hh * hh; } }
          ss = half_sum(ss); const float rs = rsqrtf(ss * (1.f / 64.f) + RMS_EPS);
#pragma unroll
          for (int d0 = 0; d0 < 4; ++d0) { const f32x4 w0 = *(const f32x4*)(qw + d0 * 16 + hi * 8), w1 = *(const f32x4*)(qw + d0 * 16 + hi * 8 + 4);
              u32x4 o; o.x = cvtpk(bflo(raw[d0].x) * rs * w0.x, bfhi(raw[d0].x) * rs * w0.y); o.y = cvtpk(bflo(raw[d0].y) * rs * w0.z, bfhi(raw[d0].y) * rs * w0.w);
              o.z = cvtpk(bflo(raw[d0].z) * rs * w1.x, bfhi(raw[d0].z) * rs * w1.y); o.w = cvtpk(bflo(raw[d0].w) * rs * w1.z, bfhi(raw[d0].w) * rs * w1.w);
              qr[d0] = *reinterpret_cast<bf16x8*>(&o); } }
        float m_reg = sink, l_reg = 1.f; f32x16 o2[2] = {};
        const int tile0 = q0 >> 6;
#pragma unroll 1
        for (int tt = 0; tt < 3; ++tt) {
            const int tile = tile0 + tt;
            if (n == 0 && tile < 2) continue;
            f32x16 p0, p1; qkt<4>(p0, p1, K_lds + tile * SHM_K, r32, hi, qr);
            const int dq = 128 + q0 + r32 - tile * 64 - 4 * hi;
#pragma unroll
            for (int r = 0; r < 16; ++r) { const int c = (r & 3) + 8 * (r >> 2); const int d0_ = dq - c, d1_ = d0_ - 32;
                const float b0_ = bt[d0_ & 127], b1_ = bt[d1_ & 127];
                p0[r] = ((unsigned)d0_ < 128u) ? fmaf(p0[r], 0.125f, b0_) : -INFINITY; p1[r] = ((unsigned)d1_ < 128u) ? fmaf(p1[r], 0.125f, b1_) : -INFINITY; }
            float pmax = p0[0];
#pragma unroll
            for (int r = 1; r < 16; ++r) pmax = fmaxf(pmax, p0[r]);
#pragma unroll
            for (int r = 0; r < 16; ++r) pmax = fmaxf(pmax, p1[r]);
            pmax = half_max(pmax);
            const float mn = fmaxf(m_reg, pmax), alpha = __builtin_amdgcn_exp2f((m_reg - mn) * LOG2E); m_reg = mn;
            const float mnl = -mn * LOG2E; float psum = 0.f;
#pragma unroll
            for (int r = 0; r < 16; ++r) { p0[r] = __builtin_amdgcn_exp2f(fmaf(p0[r], LOG2E, mnl)); p1[r] = __builtin_amdgcn_exp2f(fmaf(p1[r], LOG2E, mnl)); psum += p0[r] + p1[r]; }
            psum = half_sum(psum); l_reg = l_reg * alpha + psum;
            bf16x8 pa0, pa1, pa2, pa3; pack_p(p0, p1, pa0, pa1, pa2, pa3);
            if (__any(alpha < 1.f)) { if (hi == 0) al_l[r32] = alpha; asm volatile("s_waitcnt lgkmcnt(0)" ::: "memory");
#pragma unroll
                for (int d_ = 0; d_ < 2; ++d_)
#pragma unroll
                    for (int r = 0; r < 16; ++r) o2[d_][r] *= al_l[crow(r, hi)]; }
            pv_tile<0, 2>(o2, vb0 + tile * SHM_V, pa0, pa1, pa2, pa3);
        }
        if (hi == 0) li_l[r32] = l_reg; asm volatile("s_waitcnt lgkmcnt(0)" ::: "memory");
        bf16* Ow = (bf16*)(P.ws + WS_MIX) + ((size_t)b * SEQ + n * 128 + q0) * DM + h * 64;
#pragma unroll
        for (int r = 0; r < 16; ++r) { const int orow = crow(r, hi); const float rl = __builtin_amdgcn_rcpf(li_l[orow]);
#pragma unroll
            for (int d0 = 0; d0 < 2; ++d0) { const float v = o2[d0][r] * rl; const float vn = __shfl_xor(v, 1);
                if ((r32 & 1) == 0) *(unsigned*)(Ow + (size_t)orow * DM + d0 * 32 + r32) = cvtpk(v, vn); } }
        asm volatile("s_waitcnt lgkmcnt(0)" ::: "memory");
    }
    __syncthreads();
}
DEV void phase_swa(const Params& P, unsigned char* lds, int vb, int nvb, int layer) {
    { const int tid = opaque_tid(); if (tid < 64) { ((float*)(lds + S_QW))[tid] = P.in[I_AQN][(layer >> 1) * 64 + tid]; ((float*)(lds + S_KW))[tid] = P.in[I_AKN][(layer >> 1) * 64 + tid]; } }
    __syncthreads();
    for (int it = vb; it < NBATCH * 2 * 32; it += nvb) swa_unit(P, (char*)lds, layer, it >> 6, (it >> 5) & 1, it & 31);
}

constexpr int G_G = 0, G_K = 16384, G_V = 32768, G_S = 49152, G_QD = 65536, G_KT = 73728, G_SEG = 81920, G_WS = 83968;
DEV void gla_gates(const Params& P, char* lds, int layer, int b, int h, int n, int tid) {
    const int seg = tid >> 6, dk = tid & 63, jl = layer >> 1;
    float* G = (float*)(lds + G_G); float* segs = (float*)(lds + G_SEG);
    float gu[16];
#pragma unroll
    for (int r = 0; r < 16; ++r) gu[r] = P.in[I_BGU][((size_t)jl * 16 + r) * 256 + h * 64 + dk];
    const float bias = P.in[I_BGB][jl * 256 + h * 64 + dk];
    const float* AB = (const float*)(P.ws + WS_AB) + ((size_t)b * SEQ + n * 64 + seg * 8) * 16;
    float vals[8], run = 0.f;
#pragma unroll
    for (int i = 0; i < 8; ++i) { const f32x4 a0 = *(const f32x4*)(AB + i * 16), a1 = *(const f32x4*)(AB + i * 16 + 4), a2 = *(const f32x4*)(AB + i * 16 + 8), a3 = *(const f32x4*)(AB + i * 16 + 12);
        float z = bias;
        z += a0.x * gu[0] + a0.y * gu[1] + a0.z * gu[2] + a0.w * gu[3]; z += a1.x * gu[4] + a1.y * gu[5] + a1.z * gu[6] + a1.w * gu[7];
        z += a2.x * gu[8] + a2.y * gu[9] + a2.z * gu[10] + a2.w * gu[11]; z += a3.x * gu[12] + a3.y * gu[13] + a3.z * gu[14] + a3.w * gu[15];
        run += log_sigmoid_f(z) * (1.f / 16.f); vals[i] = run; }
    segs[seg * 64 + dk] = run;
    __syncthreads();
    float pre = 0.f;
#pragma unroll
    for (int s = 0; s < 8; ++s) pre += (s < seg) ? segs[s * 64 + dk] : 0.f;
#pragma unroll
    for (int i = 0; i < 8; ++i) G[(seg * 8 + i) * 64 + dk] = vals[i] + pre;
    __syncthreads();
}
DEV void gla_stage_v(const bf16* src, size_t pitch, char* dst, int tid) {
#pragma unroll
    for (int i = 0; i < 2; ++i) { const int idx = tid + 512 * i, row = idx >> 4, ch = idx & 15; *(u32x4*)(dst + v_st(row, ch * 8)) = *(const u32x4*)(src + (size_t)row * pitch + ch * 8); }
}
DEV void gla_local_unit(const Params& P, char* lds, int layer, int b, int h, int n) {
    const int tid = opaque_tid(), wid = __builtin_amdgcn_readfirstlane(tid >> 6), lane = tid & 63, r32 = lane & 31, hi = lane >> 5;
    const bf16* QKV = (const bf16*)(P.ws + WS_BIG); const float* G = (const float*)(lds + G_G);
    const int chd = (b * 4 + h) * 64 + n; const size_t tok0 = (size_t)b * SEQ + n * 64;
    gla_gates(P, lds, layer, b, h, n, tid);
    { const int j = tid >> 3, c8 = (tid & 7) * 8; const u32x4 kr = *(const u32x4*)(QKV + (tok0 + j) * EVN + 1024 + h * 64 + c8);
      const float kf[8] = {bflo(kr.x), bfhi(kr.x), bflo(kr.y), bfhi(kr.y), bflo(kr.z), bfhi(kr.z), bflo(kr.w), bfhi(kr.w)};
      bf16* kdT = (bf16*)(lds + G_KT);
#pragma unroll
      for (int e = 0; e < 8; ++e) { const float bl = G[63 * 64 + c8 + e], bj = G[j * 64 + c8 + e]; kdT[(c8 + e) * 64 + j] = (bf16)f2bf(kf[e] * __expf(bl - bj));
          if (j == 63) ((float*)(P.ws + WS_DEC))[(size_t)chd * 64 + c8 + e] = __expf(bl); } }
    gla_stage_v(QKV + tok0 * EVN + 1280 + h * 128, EVN, lds + G_V, tid);
    __syncthreads();
    const int rh = wid >> 2, dq = wid & 3;
    bf16x8 pa[4];
#pragma unroll
    for (int ks = 0; ks < 4; ++ks) pa[ks] = *(const bf16x8*)(lds + G_KT + ((32 * rh + r32) * 64 + ks * 16 + hi * 8) * 2);
    f32x16 o1[1] = {};
    pv_tile<0, 1>(o1, (int)(uintptr_t)(lds + G_V) + v_rd_base(lane) + dq * 512, pa[0], pa[1], pa[2], pa[3]);
    float* UPD = (float*)(P.ws + WS_UPD) + (size_t)chd * 64 * 128;
#pragma unroll
    for (int r = 0; r < 16; ++r) UPD[(32 * rh + crow(r, hi)) * 128 + dq * 32 + r32] = o1[0][r];
    __syncthreads();
}
DEV void phase_gla_scan(const Params& P, int vb, int nvb) {
    const int tid = opaque_tid();
    const float* UPD = (const float*)(P.ws + WS_UPD); const float* DEC = (const float*)(P.ws + WS_DEC); bf16* SIN = (bf16*)(P.ws + WS_SIN);
    for (int e = vb * 512 + tid; e < 32 * 64 * 64; e += nvb * 512) {
        const int dvp = e & 63, dk = (e >> 6) & 63, bh = e >> 12;
        float s0 = 0.f, s1 = 0.f;
#pragma unroll 8
        for (int n = 0; n < 64; ++n) { const size_t ro = ((size_t)(bh * 64 + n) * 64 + dk);
            const f32x2 u = *(const f32x2*)(UPD + ro * 128 + 2 * dvp); const float d = DEC[ro];
            *(unsigned*)(SIN + ro * 128 + 2 * dvp) = pk2(s0, s1);
            s0 = s0 * d + u.x; s1 = s1 * d + u.y; }
    }
}
DEV void gla_final_unit(const Params& P, char* lds, int layer, int b, int h, int n) {
    const int tid = opaque_tid(), wid = __builtin_amdgcn_readfirstlane(tid >> 6), lane = tid & 63, r32 = lane & 31, hi = lane >> 5;
    const bf16* QKV = (const bf16*)(P.ws + WS_BIG); const float* G = (const float*)(lds + G_G);
    const int chd = (b * 4 + h) * 64 + n, jl = layer >> 1; const size_t tok0 = (size_t)b * SEQ + n * 64;
    gla_gates(P, lds, layer, b, h, n, tid);
    { const int j = tid >> 3, c8 = (tid & 7) * 8; const bf16* rp = QKV + (tok0 + j) * EVN + h * 64 + c8;
      const u32x4 qv = *(const u32x4*)(rp + 768), kr = *(const u32x4*)(rp + 1024);
      const float qf_[8] = {bflo(qv.x), bfhi(qv.x), bflo(qv.y), bfhi(qv.y), bflo(qv.z), bfhi(qv.z), bflo(qv.w), bfhi(qv.w)};
      const float kf[8] = {bflo(kr.x), bfhi(kr.x), bflo(kr.y), bfhi(kr.y), bflo(kr.z), bfhi(kr.z), bflo(kr.w), bfhi(kr.w)};
      float qd_[8], ki_[8];
#pragma unroll
      for (int e = 0; e < 8; ++e) { const float bj = G[j * 64 + c8 + e]; qd_[e] = qf_[e] * 0.125f * __expf(bj); ki_[e] = kf[e] * __expf(-bj); }
      *(u32x4*)(lds + G_QD + (j * 64 + c8) * 2) = (u32x4){cvtpk(qd_[0], qd_[1]), cvtpk(qd_[2], qd_[3]), cvtpk(qd_[4], qd_[5]), cvtpk(qd_[6], qd_[7])};
      *(u32x4*)(lds + G_K + KSWZ(j, c8 * 2)) = (u32x4){cvtpk(ki_[0], ki_[1]), cvtpk(ki_[2], ki_[3]), cvtpk(ki_[4], ki_[5]), cvtpk(ki_[6], ki_[7])}; }
    gla_stage_v(QKV + tok0 * EVN + 1280 + h * 128, EVN, lds + G_V, tid);
    gla_stage_v((const bf16*)(P.ws + WS_SIN) + (size_t)chd * 64 * 128, 128, lds + G_S, tid);
    __syncthreads();
    const int rh = wid >> 2, dq = wid & 3, irow = 32 * rh + r32;
    bf16x8 qf[4];
#pragma unroll
    for (int d0 = 0; d0 < 4; ++d0) qf[d0] = *(const bf16x8*)(lds + G_QD + (irow * 64 + d0 * 16 + hi * 8) * 2);
    f32x16 p0, p1; qkt<4>(p0, p1, lds + G_K, r32, hi, qf);
#pragma unroll
    for (int r = 0; r < 16; ++r) { const int jj = crow(r, hi); p0[r] = (irow >= jj) ? p0[r] : 0.f; p1[r] = (irow >= jj + 32) ? p1[r] : 0.f; }
    bf16x8 pa0, pa1, pa2, pa3; pack_p(p0, p1, pa0, pa1, pa2, pa3);
    f32x16 o1[1] = {};
    pv_tile<0, 1>(o1, (int)(uintptr_t)(lds + G_V) + v_rd_base(lane) + dq * 512, pa0, pa1, pa2, pa3);
    pv_tile<0, 1>(o1, (int)(uintptr_t)(lds + G_S) + v_rd_base(lane) + dq * 512, qf[0], qf[1], qf[2], qf[3]);
    __syncthreads();
    float* obuf = (float*)lds;
#pragma unroll
    for (int r = 0; r < 16; ++r) obuf[(32 * rh + crow(r, hi)) * 128 + dq * 32 + r32] = o1[0][r];
    __syncthreads();
    { const int row = tid >> 3, c16 = (tid & 7) * 16; float ov[16]; float ss = 0.f;
#pragma unroll
      for (int q = 0; q < 4; ++q) { const f32x4 t = *(const f32x4*)(obuf + row * 128 + c16 + 4 * q); ov[4 * q] = t.x; ov[4 * q + 1] = t.y; ov[4 * q + 2] = t.z; ov[4 * q + 3] = t.w; ss += (t.x * t.x + t.y * t.y) + (t.z * t.z + t.w * t.w); }
      ss += __shfl_xor(ss, 1); ss += __shfl_xor(ss, 2); ss += __shfl_xor(ss, 4);
      const float rs = rsqrtf(ss * (1.f / 128.f) + RMS_EPS);
      const bf16* rb = QKV + (tok0 + row) * EVN + 1792 + h * 128 + c16; const float* on = P.in[I_BON] + jl * 128 + c16;
      bf16* op = (bf16*)(P.ws + WS_MIX) + (tok0 + row) * DM + 512 + h * 128 + c16;
#pragma unroll
      for (int hf = 0; hf < 2; ++hf) { const u32x4 gv = *(const u32x4*)(rb + 8 * hf); const f32x4 n0 = *(const f32x4*)(on + 8 * hf), n1 = *(const f32x4*)(on + 8 * hf + 4);
          const float* o8 = ov + 8 * hf;
          u32x4 w; w.x = cvtpk(o8[0] * rs * n0.x * silu_f(bflo(gv.x)), o8[1] * rs * n0.y * silu_f(bfhi(gv.x))); w.y = cvtpk(o8[2] * rs * n0.z * silu_f(bflo(gv.y)), o8[3] * rs * n0.w * silu_f(bfhi(gv.y)));
          w.z = cvtpk(o8[4] * rs * n1.x * silu_f(bflo(gv.z)), o8[5] * rs * n1.y * silu_f(bfhi(gv.z))); w.w = cvtpk(o8[6] * rs * n1.z * silu_f(bflo(gv.w)), o8[7] * rs * n1.w * silu_f(bfhi(gv.w)));
          *(u32x4*)(op + 8 * hf) = w; } }
    __syncthreads();
}
DEV void phase_gla_local(const Params& P, unsigned char* lds, int vb, int nvb, int layer) { for (int it = vb; it < 2048; it += nvb) gla_local_unit(P, (char*)lds, layer, it >> 8, (it >> 6) & 3, it & 63); }
DEV void phase_gla_final(const Params& P, unsigned char* lds, int vb, int nvb, int layer) { for (int it = vb; it < 2048; it += nvb) gla_final_unit(P, (char*)lds, layer, it >> 8, (it >> 6) & 3, it & 63); }
#undef KSWZ
#undef SBAR
}

template <int EPI  >
__global__ void __launch_bounds__(256) k_gemm_naive(const bf16* A, int lda, const float* W, int ldw, int K, int N, bf16* Ob, int ldc, const float* xin, float* xout, const float* gate) {
    const int col = (blockIdx.x * 64 + threadIdx.x) * 4, r0 = blockIdx.y * 16 + threadIdx.y * 4;
    if (col >= N) return;
    f32x4 acc[4];
#pragma unroll
    for (int i = 0; i < 4; ++i) acc[i] = (f32x4){0.f, 0.f, 0.f, 0.f};
    const bf16* a0 = A + (size_t)r0 * lda;
    for (int k = 0; k < K; ++k) {
        const f32x4 w = *(const f32x4*)(W + (size_t)k * ldw + col);
#pragma unroll
        for (int i = 0; i < 4; ++i) acc[i] += w * bf2f(a0[(size_t)i * lda + k]);
    }
#pragma unroll
    for (int i = 0; i < 4; ++i) {
        const int r = r0 + i;
        if (EPI == 0) { u32x2 o; o.x = pk2(acc[i].x, acc[i].y); o.y = pk2(acc[i].z, acc[i].w); *(u32x2*)(Ob + (size_t)r * ldc + col) = o; }
        else { const f32x4 g = *(const f32x4*)(gate + (size_t)(r >> 12) * (6 * DM) + col); const f32x4 xi = *(const f32x4*)(xin + (size_t)r * DM + col);
            *(f32x4*)(xout + (size_t)r * DM + col) = xi + g * acc[i]; }
    }
}
__global__ void __launch_bounds__(256) k_moe_up_naive(Params P, int layer) {
    const int col = (blockIdx.x * 64 + threadIdx.x) * 4, r0 = blockIdx.y * 16 + threadIdx.y * 4;
    const unsigned* cnt = (const unsigned*)(P.ws + WS_CTL) + CW_CNT + layer * 32;
    int e = -1, base = 0;
    { int a = 0; for (int i = 0; i < NEXP; ++i) { const int pc = ((int)cnt[i] + 255) & ~255; if (r0 >= a && r0 < a + pc) { e = i; base = a; } a += pc; } }
    if (e < 0) return;
    const int n = (int)cnt[e]; const int* LIST = (const int*)(P.ws + WS_LIST) + (size_t)e * NTOK;
    int tok[4]; bool ok[4];
#pragma unroll
    for (int i = 0; i < 4; ++i) { const int s = r0 + i - base; ok[i] = s < n; tok[i] = ok[i] ? (LIST[s] >> 1) : 0; }
    const bf16* H = (const bf16*)(P.ws + WS_H);
    const float* w1 = P.in[I_MW1] + ((size_t)layer * NEXP + e) * DM * MOEH + col; const float* w3 = P.in[I_MW3] + ((size_t)layer * NEXP + e) * DM * MOEH + col;
    f32x4 a1[4], a3[4];
#pragma unroll
    for (int i = 0; i < 4; ++i) { a1[i] = (f32x4){0.f, 0.f, 0.f, 0.f}; a3[i] = a1[i]; }
    for (int k = 0; k < DM; ++k) {
        const f32x4 u = *(const f32x4*)(w1 + (size_t)k * MOEH), w = *(const f32x4*)(w3 + (size_t)k * MOEH);
#pragma unroll
        for (int i = 0; i < 4; ++i) { const float hv = bf2f(H[(size_t)tok[i] * DM + k]); a1[i] += u * hv; a3[i] += w * hv; }
    }
    bf16* ACT = (bf16*)(P.ws + WS_ACT);
#pragma unroll
    for (int i = 0; i < 4; ++i) if (ok[i]) { u32x2 o; o.x = pk2(silu_f(a1[i].x) * a3[i].x, silu_f(a1[i].y) * a3[i].y); o.y = pk2(silu_f(a1[i].z) * a3[i].z, silu_f(a1[i].w) * a3[i].w);
        *(u32x2*)(ACT + (size_t)(r0 + i) * MOEH + col) = o; }
}
__global__ void __launch_bounds__(256) k_moe_down_naive(Params P, int layer) {
    const int col = (blockIdx.x * 64 + threadIdx.x) * 4, r0 = blockIdx.y * 16 + threadIdx.y * 4;
    const unsigned* cnt = (const unsigned*)(P.ws + WS_CTL) + CW_CNT + layer * 32;
    int e = -1, base = 0;
    { int a = 0; for (int i = 0; i < NEXP; ++i) { const int pc = ((int)cnt[i] + 255) & ~255; if (r0 >= a && r0 < a + pc) { e = i; base = a; } a += pc; } }
    if (e < 0) return;
    const int n = (int)cnt[e];
    if (r0 - base >= n) return;
    const bf16* ACT = (const bf16*)(P.ws + WS_ACT) + (size_t)r0 * MOEH;
    const float* w2 = P.in[I_MW2] + ((size_t)layer * NEXP + e) * MOEH * DM + col;
    f32x4 acc[4];
#pragma unroll
    for (int i = 0; i < 4; ++i) acc[i] = (f32x4){0.f, 0.f, 0.f, 0.f};
    for (int k = 0; k < MOEH; ++k) {
        const f32x4 w = *(const f32x4*)(w2 + (size_t)k * DM);
#pragma unroll
        for (int i = 0; i < 4; ++i) acc[i] += w * ((r0 + i - base < n) ? bf2f(ACT[(size_t)i * MOEH + k]) : 0.f);
    }
    bf16* YP = (bf16*)(P.ws + WS_YP);
#pragma unroll
    for (int i = 0; i < 4; ++i) if (r0 + i - base < n) { u32x2 o; o.x = pk2(acc[i].x, acc[i].y); o.y = pk2(acc[i].z, acc[i].w); *(u32x2*)(YP + (size_t)(r0 + i) * DM + col) = o; }
}
__global__ void __launch_bounds__(512) k_swa_naive(Params P, int layer) {
    __shared__ float qs[8][64];
    const int r = blockIdx.x, lane = threadIdx.x & 63, h = threadIdx.x >> 6, kvh = h >> 2, b = r >> 12, t = r & (SEQ - 1), jl = layer >> 1;
    const bf16* QKV = (const bf16*)(P.ws + WS_BIG); const float* BT = (const float*)(P.ws + WS_BT);
    { const float q = bf2f(QKV[(size_t)r * EVN + h * 64 + lane]); const float rs = rsqrtf(wave_sum(q * q) * (1.f / 64.f) + RMS_EPS);
      qs[h][lane] = q * rs * P.in[I_AQN][jl * 64 + lane] * P.in[I_AKN][jl * 64 + lane]; }
    __syncthreads();
    float lg[2];
#pragma unroll
    for (int i = 0; i < 2; ++i) { const int dist = i * 64 + lane, s = t - dist; lg[i] = -INFINITY;
        if (s >= 0) { const bf16* kr = QKV + ((size_t)b * SEQ + s) * EVN + 512 + kvh * 64; float dot = 0.f, kss = 0.f;
#pragma unroll 8
            for (int d = 0; d < 64; ++d) { const float kv = bf2f(kr[d]); dot += qs[h][d] * kv; kss += kv * kv; }
            lg[i] = dot * rsqrtf(kss * (1.f / 64.f) + RMS_EPS) * 0.125f + BT[h * 128 + dist]; } }
    const float sink = P.in[I_ASINK][jl * 8 + h];
    const float m = fmaxf(wave_max(fmaxf(lg[0], lg[1])), sink);
    float p[2];
#pragma unroll
    for (int i = 0; i < 2; ++i) p[i] = (lg[i] == -INFINITY) ? 0.f : __expf(lg[i] - m);
    const float den = wave_sum(p[0] + p[1]) + __expf(sink - m);
    float o = 0.f;
#pragma unroll
    for (int i = 0; i < 2; ++i)
        for (int src = 0; src < 64; ++src) { const float ps = __shfl(p[i], src); const int s = t - (i * 64 + src);
            if (s >= 0) o += ps * bf2f(QKV[((size_t)b * SEQ + s) * EVN + 640 + kvh * 64 + lane]); }
    ((bf16*)(P.ws + WS_MIX))[(size_t)r * DM + h * 64 + lane] = (bf16)f2bf(o / den);
}
__global__ void __launch_bounds__(256) k_gla_decay_naive(Params P, int layer) {
    const int r = blockIdx.x, c = threadIdx.x, jl = layer >> 1;
    const float* ab = (const float*)(P.ws + WS_AB) + (size_t)r * 16; const float* gu = P.in[I_BGU] + (size_t)jl * 16 * 256;
    float z = P.in[I_BGB][jl * 256 + c];
#pragma unroll
    for (int j = 0; j < 16; ++j) z += ab[j] * gu[j * 256 + c];
    ((float*)(P.ws + WS_UPD))[(size_t)r * 256 + c] = __expf(log_sigmoid_f(z) * (1.f / 16.f));
}
__global__ void __launch_bounds__(128) k_gla_scan_naive(Params P, int layer) {
    const int b = blockIdx.x >> 2, h = blockIdx.x & 3, dv = threadIdx.x;
    const bf16* QKV = (const bf16*)(P.ws + WS_BIG); const float* A = (const float*)(P.ws + WS_UPD); float* O = (float*)(P.ws + WS_SIN);
    float S[64];
#pragma unroll
    for (int d = 0; d < 64; ++d) S[d] = 0.f;
    for (int t = 0; t < SEQ; ++t) {
        const size_t r = (size_t)b * SEQ + t;
        const bf16* row = QKV + r * EVN; const float* ar = A + r * 256 + h * 64;
        const float v = bf2f(row[1280 + h * 128 + dv]);
        float o = 0.f;
#pragma unroll
        for (int d = 0; d < 64; ++d) { S[d] = ar[d] * S[d] + bf2f(row[1024 + h * 64 + d]) * v; o += bf2f(row[768 + h * 64 + d]) * S[d]; }
        O[r * 512 + h * 128 + dv] = o * 0.125f;
    }
}
__global__ void __launch_bounds__(256) k_gla_fin_naive(Params P, int layer) {
    const int r = blockIdx.x, lane = threadIdx.x & 63, h = threadIdx.x >> 6, jl = layer >> 1;
    const float* O = (const float*)(P.ws + WS_SIN) + (size_t)r * 512 + h * 128 + 2 * lane; const bf16* QKV = (const bf16*)(P.ws + WS_BIG);
    const float o0 = O[0], o1 = O[1]; const float rs = rsqrtf(wave_sum(o0 * o0 + o1 * o1) * (1.f / 128.f) + RMS_EPS);
    const unsigned g = *(const unsigned*)(QKV + (size_t)r * EVN + 1792 + h * 128 + 2 * lane);
    const float* on = P.in[I_BON] + jl * 128 + 2 * lane;
    *(unsigned*)((bf16*)(P.ws + WS_MIX) + (size_t)r * DM + 512 + h * 128 + 2 * lane) = pk2(o0 * rs * on[0] * silu_f(bflo(g)), o1 * rs * on[1] * silu_f(bfhi(g)));
}
__global__ void __launch_bounds__(512) k_moba_naive(Params P, int layer) {
    __shared__ float qs[8][128];
    const int r = blockIdx.x, lane = threadIdx.x & 63, h = threadIdx.x >> 6, b = r >> 12, t = r & (SEQ - 1), qblk = t >> 8, jl = layer >> 1;
    const bf16* QKV = (const bf16*)(P.ws + WS_BIG); const float* BT = (const float*)(P.ws + WS_BT) + h * 128; const float* KM = (const float*)(P.ws + WS_KMEAN);
    { const unsigned u = *(const unsigned*)(QKV + (size_t)r * ODN + h * 128 + 2 * lane); const float q0 = bflo(u), q1 = bfhi(u);
      const float rs = rsqrtf(wave_sum(q0 * q0 + q1 * q1) * (1.f / 128.f) + RMS_EPS); const float* qn = P.in[I_CQN] + jl * 128 + 2 * lane;
      qs[h][2 * lane] = q0 * rs * qn[0]; qs[h][2 * lane + 1] = q1 * rs * qn[1]; }
    __syncthreads();
    float sc = -INFINITY;
    if (lane < qblk) { const float* km = KM + (((size_t)b * 16 + lane) * 8 + h) * 128; float d = 0.f; for (int i = 0; i < 128; ++i) d += qs[h][i] * km[i]; sc = d; }
    int blk[4]; blk[0] = qblk;
#pragma unroll
    for (int n = 0; n < 3; ++n) { const float mx = wave_max(sc); const unsigned long long bal = __ballot(sc == mx && mx > -INFINITY);
        const int idx = bal ? (__ffsll((long long)bal) - 1) : -1; blk[1 + n] = idx; if (lane == idx) sc = -INFINITY; }
    float lg[4][4];
#pragma unroll
    for (int s = 0; s < 4; ++s)
#pragma unroll
        for (int rr = 0; rr < 4; ++rr) { lg[s][rr] = -INFINITY;
            if (blk[s] >= 0) { const int key = blk[s] * 256 + rr * 64 + lane, dist = t - key;
                if (dist >= 0) { const bf16* kr = QKV + ((size_t)b * SEQ + key) * ODN + 1024 + h * 128; float dot = 0.f;
#pragma unroll 8
                    for (int d = 0; d < 128; ++d) dot += qs[h][d] * bf2f(kr[d]);
                    lg[s][rr] = dot * 0.08838834764831845f + BT[dist < 127 ? dist : 127]; } } }
    float m = -INFINITY;
#pragma unroll
    for (int s = 0; s < 4; ++s)
#pragma unroll
        for (int rr = 0; rr < 4; ++rr) m = fmaxf(m, lg[s][rr]);
    m = wave_max(m);
    float den = 0.f;
#pragma unroll
    for (int s = 0; s < 4; ++s)
#pragma unroll
        for (int rr = 0; rr < 4; ++rr) { lg[s][rr] = (lg[s][rr] == -INFINITY) ? 0.f : __expf(lg[s][rr] - m); den += lg[s][rr]; }
    den = wave_sum(den);
    float o0 = 0.f, o1 = 0.f;
#pragma unroll
    for (int s = 0; s < 4; ++s)
#pragma unroll
        for (int rr = 0; rr < 4; ++rr) {
            if (blk[s] < 0) continue;
            for (int src = 0; src < 64; ++src) { const float ps = __shfl(lg[s][rr], src); const int key = blk[s] * 256 + rr * 64 + src;
                if (key <= t) { const unsigned u = *(const unsigned*)(QKV + ((size_t)b * SEQ + key) * ODN + 2048 + h * 128 + 2 * lane); o0 += ps * bflo(u); o1 += ps * bfhi(u); } } }
    *(unsigned*)((bf16*)(P.ws + WS_MIX) + (size_t)r * DM + h * 128 + 2 * lane) = pk2(o0 / den, o1 / den);
}

#define XB_TMO      128
#define XB_XCNT(j)  (256  + 64 * (j))
#define XB_XSUB(j)  (1280 + 64 * (j))
#define XB_XGEN(j)  (2304 + 64 * (j))
#define XB_TOP      3328
#define XB_TOPGEN   3392
#define XCD_BAR_WORDS 3456
#define XB_SPIN_CAP (1u << 18)
#define LAS __attribute__((address_space(3)))

__device__ __forceinline__ unsigned xb_ld(unsigned* p)              { return __hip_atomic_load(p, __ATOMIC_RELAXED, __HIP_MEMORY_SCOPE_AGENT); }
__device__ __forceinline__ unsigned xb_add(unsigned* p, unsigned v) { return __hip_atomic_fetch_add(p, v, __ATOMIC_RELAXED, __HIP_MEMORY_SCOPE_AGENT); }
__device__ __forceinline__ unsigned xb_xcc_id() { return (unsigned)__builtin_amdgcn_s_getreg((3 << 11) | 20) & 0xFu; }
#define XB_SPIN(cond, bar) do { unsigned _sp = 0; while (cond) { __builtin_amdgcn_s_sleep(1); \
    if ((++_sp & 255u) == 0u) { if (xb_ld(&(bar)[XB_TMO])) break; if (_sp > XB_SPIN_CAP) { atomicAdd(&(bar)[XB_TMO], 1u); break; } } } } while (0)

struct XcdBarrier {
    unsigned* bar; unsigned x;
    volatile LAS unsigned* st;
};
__device__ __forceinline__ XcdBarrier xcd_barrier_post(unsigned* bar, volatile LAS unsigned* st) {
    XcdBarrier b; b.bar = bar; b.x = xb_xcc_id(); b.st = st;
    if (threadIdx.x == 0) (void)xb_add(&bar[XB_XCNT(b.x)], 1u);
    return b;
}
__device__ __forceinline__ void xcd_barrier_complete(unsigned* bar, unsigned x, unsigned& nloc, unsigned& nx) {
    const unsigned G = gridDim.x * gridDim.y * gridDim.z;
    unsigned sum, cnt, mine, sp = 0u;
    for (;;) {
        sum = 0u; cnt = 0u; mine = 0u;
#pragma unroll
        for (unsigned j = 0; j < 16; ++j) { const unsigned c = xb_ld(&bar[XB_XCNT(j)]); sum += c; cnt += (c > 0u) ? 1u : 0u; mine = (j == x) ? c : mine; }
        if (sum == G) break;
        __builtin_amdgcn_s_sleep(1);
        if ((++sp & 255u) == 0u) { if (xb_ld(&bar[XB_TMO])) break; if (sp > XB_SPIN_CAP) { atomicAdd(&bar[XB_TMO], 1u); break; } }
    }
    nloc = mine > 0u ? mine : 1u; nx = cnt > 0u ? cnt : 1u;
}
__device__ __forceinline__ void xcd_barrier(const XcdBarrier& b) {
    asm volatile("s_waitcnt vmcnt(0)" ::: "memory");
    __syncthreads();
    if (threadIdx.x == 0) {
        unsigned* bar = b.bar;
        __builtin_amdgcn_s_waitcnt(0);
        unsigned nloc = b.st[0], nx = b.st[1];
        if (nloc == 0u) { xcd_barrier_complete(bar, b.x, nloc, nx); b.st[0] = nloc; b.st[1] = nx; }
        const unsigned old = xb_add(&bar[XB_XSUB(b.x)], 1u);
        const unsigned gen = old / nloc;
        if (old + 1u == (gen + 1u) * nloc) {
            __builtin_amdgcn_fence(__ATOMIC_RELEASE, "agent");
            asm volatile("s_waitcnt vmcnt(0)" ::: "memory");
            const unsigned og = xb_add(&bar[XB_TOP], 1u);
            const unsigned tg = og / nx;
            if (og + 1u == (tg + 1u) * nx) xb_add(&bar[XB_TOPGEN], 1u);
            else XB_SPIN(xb_ld(&bar[XB_TOPGEN]) == tg, bar);
            __builtin_amdgcn_fence(__ATOMIC_ACQUIRE, "agent");
            xb_add(&bar[XB_XGEN(b.x)], 1u);
            asm volatile("s_waitcnt vmcnt(0)" ::: "memory");
        } else {
            XB_SPIN(xb_ld(&bar[XB_XGEN(b.x)]) == gen, bar);
            __builtin_amdgcn_fence(__ATOMIC_ACQUIRE, "agent");
            asm volatile("s_waitcnt vmcnt(0)" ::: "memory");
        }
    }
    __syncthreads();
}

constexpr int LDS_AUX_OFF = 147456, LDS_MISC_OFF = 151552, LDS_BYTES = 155648;
constexpr int N_PHASES = 36;
#ifndef REP
#define REP -1
#endif
#define RUN(k, ...) do { { const int dry = 0; (void)dry; __VA_ARGS__; } if (REP == (k)) { const int dry = P.pad; (void)dry; __VA_ARGS__; } } while (0)
__global__ void __launch_bounds__(512, 2) mega(Params P) {
    extern __shared__ __attribute__((aligned(16))) unsigned char lds[];
    const int tid = threadIdx.x;
    const int G = gridDim.x, bx = blockIdx.x, vcu = (G % 8 == 0) ? (bx % 8) * (G / 8) + bx / 8 : bx;
    volatile LAS unsigned* MISC = (volatile LAS unsigned*)(lds + LDS_MISC_OFF);
    if (tid < 8) MISC[tid] = 0u;
    __syncthreads();
    unsigned* ctl = (unsigned*)(P.ws + WS_CTL);
    const XcdBarrier bar = xcd_barrier_post(ctl + CW_BAR + P.li * XCD_BAR_WORDS, MISC);
    const int lo = P.ph_lo, hi = P.ph_hi; int ph = 0;
    float* X = P.out; float* MOD = (float*)(P.ws + WS_MOD);
    bf16* H = (bf16*)(P.ws + WS_H); bf16* QKV = (bf16*)(P.ws + WS_BIG); bf16* MIX = (bf16*)(P.ws + WS_MIX); bf16* ACT = (bf16*)(P.ws + WS_ACT); bf16* YP = (bf16*)(P.ws + WS_YP);
    PG8_LAS unsigned char* ldsg = (PG8_LAS unsigned char*)lds;
#define PH_BEGIN if (ph >= lo && ph < hi) {
#define PH_END if (ph + 1 < hi) xcd_barrier(bar); } ++ph;
    PH_BEGIN RUN(0, phase_prologue(P, lds, vcu, G, true)); PH_END
#pragma unroll 1
    for (int l = 0; l <= DEPTH; ++l) {
        const int odd = l & 1, lp = l >> 1;
        bool done = false;
#pragma unroll 1
        for (int half = 0; half < 2 && !done; ++half) {
            PH_BEGIN
                { const int mode = (l == DEPTH) ? 0 : (half ? 3 : (odd ? 2 : 1));
                  if (mode == 3) RUN(10, phase_norm(P, lds, vcu, G, mode, l, (const float*)X, (float*)nullptr, -1, dry)); else RUN(9, phase_norm(P, lds, vcu, G, mode, l, (l == 0 && !half) ? P.in[I_X] : (const float*)X, X, l - 1, dry)); }
            PH_END
            if (l == DEPTH) { done = true; continue; }
            if (!half) {
                PH_BEGIN
                    { const int N = odd ? ODN : EVN; const bf16* wt = odd ? (const bf16*)(P.ws + WS_WOI) + (size_t)lp * ODN * DM : (const bf16*)(P.ws + WS_WEI) + (size_t)lp * EVN * DM;
                      pg8::Gemm g{H, wt, DM, 0}; pg8::StaticOrder S; S.init(NTOK, N, G, bx); pg8::EpiBf16 E{QKV, N}; RUN(1, pg8::gemm_phase(ldsg, g, S, E)); }
                PH_END
                if (!odd) {
                    PH_BEGIN RUN(2, att::phase_swa(P, lds, vcu, G, l)); RUN(3, att::phase_gla_local(P, lds, vcu, G, l)); PH_END
                    PH_BEGIN RUN(4, att::phase_gla_scan(P, vcu, G)); PH_END
                    PH_BEGIN RUN(5, att::phase_gla_final(P, lds, vcu, G, l)); PH_END
                } else {
                    PH_BEGIN RUN(12, phase_kprep(P, lds, vcu, G, l, dry)); PH_END
                    PH_BEGIN RUN(6, att::phase_moba(P, lds, vcu, G, l)); PH_END
                }
                PH_BEGIN
                    { pg8::Gemm g{MIX, (const bf16*)(P.ws + (odd ? WS_WOO : WS_WEO)) + (size_t)lp * DM * DM, DM, 0}; pg8::StaticOrder S; S.init(NTOK, DM, G, bx);
                      RUN(11, { pg8::EpiResid E{(l == 0) ? P.in[I_X] : (const float*)X, X, MOD + (size_t)l * NBATCH * 6 * DM + 2 * DM, dry}; pg8::gemm_phase(ldsg, g, S, E); }); }
                PH_END
            } else {
#pragma unroll 1
                for (int dn = 0; dn < 2; ++dn) {
                    PH_BEGIN
                        { const int tid = opaque_tid(); PG8_LAS int* tp = (PG8_LAS int*)(ldsg + LDS_AUX_OFF); PG8_LAS unsigned* cl = (PG8_LAS unsigned*)(tp + 64); const unsigned* cnt = ctl + CW_CNT + l * 32;
                          if (tid == 0) { int a = 0; for (int e = 0; e < NEXP; ++e) { tp[e] = a; a += ((int)cnt[e] + 255) >> 8; } tp[NEXP] = a; }
                          if (tid < 32) cl[tid] = cnt[tid];
                          __syncthreads();
                          if (!dn) { pg8::Gemm g{H, (const bf16*)(P.ws + WS_WUP) + (size_t)l * NEXP * 1024 * DM, DM, (size_t)1024 * DM};
                              pg8::MoeOrder<true> S{tp, cl, (const int*)(P.ws + WS_LIST), tp + 256, 4, G, vcu}; pg8::EpiSiluMul E{ACT}; RUN(7, pg8::gemm_phase(ldsg, g, S, E)); }
                          else { pg8::Gemm g{ACT, (const bf16*)(P.ws + WS_WDN) + (size_t)l * NEXP * DM * MOEH, MOEH, (size_t)DM * MOEH};
                              pg8::MoeOrder<false> S{tp, cl, (const int*)(P.ws + WS_LIST), tp + 256, 4, G, vcu}; pg8::EpiBf16 E{YP, DM}; RUN(8, pg8::gemm_phase(ldsg, g, S, E)); } }
                    PH_END
                }
            }
        }
    }
#undef PH_BEGIN
#undef PH_END
}

extern "C" void kernel_launch(void* const* d_in, const int* in_sizes, int n_in, void* d_out, int out_size, void* d_ws, size_t ws_size, hipStream_t stream) {
    static int ok = 0, grid = 0;
    constexpr int LDS_NORM = LDS_BYTES;
    if (ok == 0) {
        if (n_in != N_IN || out_size != NTOK * DM || ws_size < WS_END) { fprintf(stderr, "kernel_launch: unexpected shapes (n_in %d out %d ws %zu need %zu)\n", n_in, out_size, ws_size, (size_t)WS_END); ok = -1; return; }
        int dev = 0, cus = 0;
        if (hipGetDevice(&dev) != hipSuccess || hipDeviceGetAttribute(&cus, hipDeviceAttributeMultiprocessorCount, dev) != hipSuccess) { ok = -1; return; }
        if (hipFuncSetAttribute((const void*)k_norm, hipFuncAttributeMaxDynamicSharedMemorySize, LDS_NORM) != hipSuccess) { fprintf(stderr, "kernel_launch: hipFuncSetAttribute failed\n"); ok = -1; return; }
        if (hipFuncSetAttribute((const void*)mega, hipFuncAttributeMaxDynamicSharedMemorySize, LDS_BYTES) != hipSuccess) { fprintf(stderr, "kernel_launch: hipFuncSetAttribute(mega) failed\n"); ok = -1; return; }
        int per_cu = 0;
        if (hipOccupancyMaxActiveBlocksPerMultiprocessor(&per_cu, (const void*)mega, 512, LDS_BYTES) != hipSuccess || per_cu < 1) fprintf(stderr, "kernel_launch: occupancy query says %d blocks per CU\n", per_cu);
        (void)hipGetLastError();
        grid = cus;
        ok = 1;
    }
    if (ok < 0) return;
    Params P{};
    for (int i = 0; i < N_IN; ++i) P.in[i] = (const float*)d_in[i];
    P.out = (float*)d_out; P.ws = (unsigned char*)d_ws; P.ph_lo = 0; P.ph_hi = 0; P.li = 0; P.pad = (REP >= 0) ? 1 : 0;
    (void)hipMemsetAsync((char*)d_ws + WS_CTL, 0, CTL_BYTES, stream);
    int li = 0;
    auto run = [&](int lo, int hi) { P.ph_lo = lo; P.ph_hi = hi; P.li = li++; hipLaunchKernelGGL(mega, dim3(grid), dim3(512), LDS_BYTES, stream, P); };
#if 0
    run(0, 1);
    for (int lp = 0; lp < 2; ++lp) {
        const int base = 1 + lp * 17, le = 2 * lp, lo_ = 2 * lp + 1;
        run(base + 0, base + 2);
        hipLaunchKernelGGL(k_swa_naive, dim3(NTOK), dim3(512), 0, stream, P, le);
        hipLaunchKernelGGL(k_gla_decay_naive, dim3(NTOK), dim3(256), 0, stream, P, le);
        hipLaunchKernelGGL(k_gla_scan_naive, dim3(32), dim3(128), 0, stream, P, le);
        hipLaunchKernelGGL(k_gla_fin_naive, dim3(NTOK), dim3(256), 0, stream, P, le);
        run(base + 5, base + 9);
        run(base + 9, base + 17);
    }
    run(35, 36);
#else
    run(0, N_PHASES);
#endif
}
```

```cpp
#include <hip/hip_runtime.h>
#include <cstdio>
#include <cstdint>

#define DEV __device__ __forceinline__
typedef unsigned short bf16;
typedef float f32x4 __attribute__((ext_vector_type(4)));
typedef float f32x2 __attribute__((ext_vector_type(2)));
typedef unsigned u32x2 __attribute__((ext_vector_type(2)));
typedef unsigned u32x4 __attribute__((ext_vector_type(4)));

constexpr int DM = 1024, NBATCH = 8, SEQ = 4096, NTOK = NBATCH * SEQ, DEPTH = 4;
constexpr int EVEN_IN = 2320, EVN = 2304, ODN = 3072;
constexpr int NEXP = 32, MOEH = 512, NPAIR = 2 * NTOK, MOE_ROWS = 73728;
constexpr float RMS_EPS = 1e-6f;
enum { I_X = 0, I_C, I_RELB, I_ADAW, I_ADAB, I_N1W, I_N2W, I_EWIN, I_EWOUT, I_AQN, I_AKN, I_ASINK, I_BGU, I_BGB, I_BON, I_OWIN, I_OWOUT, I_CQN, I_CKN,
       I_MWG, I_MBG, I_MWE, I_MBE, I_MW1, I_MW3, I_MW2, N_IN };
struct Params { const float* in[N_IN]; float* out; unsigned char* ws; int ph_lo, ph_hi, li, pad; };

constexpr size_t al256(size_t x) { return (x + 255) & ~(size_t)255; }
constexpr size_t WS_CTL = 0, CTL_BYTES = 1u << 20;
constexpr size_t WS_MOD = WS_CTL + CTL_BYTES;
constexpr size_t WS_BT = WS_MOD + al256((size_t)DEPTH * NBATCH * 6 * DM * 4);
constexpr size_t WS_KMEAN = WS_BT + al256(8 * 128 * 4);
constexpr size_t WS_AB = WS_KMEAN + al256((size_t)NBATCH * 16 * 8 * 128 * 4);
constexpr size_t WS_PAIRE = WS_AB + al256((size_t)NTOK * 16 * 4);
constexpr size_t WS_PAIRS = WS_PAIRE + al256((size_t)NPAIR * 4);
constexpr size_t WS_PAIRG = WS_PAIRS + al256((size_t)NPAIR * 4);
constexpr size_t WS_LIST = WS_PAIRG + al256((size_t)NPAIR * 4);
constexpr size_t WS_WEI = WS_LIST + al256((size_t)NEXP * NTOK * 4);
constexpr size_t WS_WEO = WS_WEI + al256((size_t)2 * EVN * DM * 2);
constexpr size_t WS_WOI = WS_WEO + al256((size_t)2 * DM * DM * 2);
constexpr size_t WS_WOO = WS_WOI + al256((size_t)2 * ODN * DM * 2);
constexpr size_t WS_WUP = WS_WOO + al256((size_t)2 * DM * DM * 2);
constexpr size_t WS_WDN = WS_WUP + al256((size_t)DEPTH * NEXP * 1024 * DM * 2);
constexpr size_t WS_H = WS_WDN + al256((size_t)DEPTH * NEXP * DM * MOEH * 2);
constexpr size_t WS_MIX = WS_H + al256((size_t)NTOK * DM * 2);
constexpr size_t WS_UPD = WS_MIX + al256((size_t)NTOK * DM * 2);
constexpr size_t WS_SIN = WS_UPD + al256((size_t)2048 * 64 * 128 * 4);
constexpr size_t WS_DEC = WS_SIN + al256((size_t)2048 * 64 * 128 * 4);
constexpr size_t WS_BIG = WS_DEC + al256((size_t)2048 * 64 * 4);
constexpr size_t WS_ACT = WS_BIG, WS_YP = WS_BIG + al256((size_t)MOE_ROWS * MOEH * 2);
constexpr size_t BIG_BYTES = al256((size_t)MOE_ROWS * MOEH * 2) + al256((size_t)MOE_ROWS * DM * 2);
static_assert(BIG_BYTES >= (size_t)NTOK * ODN * 2, "QKV fits the union");
constexpr size_t WS_END = WS_BIG + BIG_BYTES;
constexpr int CW_CNT = 64;
constexpr int CW_BAR = 4096;

__device__ const unsigned char REL_BUCKET[128] = {0,1,2,3,4,5,6,7,8,9,10,11,12,13,14,15,16,16,16,17,17,18,18,18,19,19,19,20,20,20,20,21,21,21,21,22,22,22,22,22,23,23,23,23,23,23,24,24,24,24,24,24,25,25,25,25,25,25,25,26,26,26,26,26,26,26,26,27,27,27,27,27,27,27,27,27,27,28,28,28,28,28,28,28,28,28,28,29,29,29,29,29,29,29,29,29,29,29,29,30,30,30,30,30,30,30,30,30,30,30,30,30,30,31,31,31,31,31,31,31,31,31,31,31,31,31,31,31};

DEV int opaque_s(int x) { asm volatile("" : "+s"(x)); return x; }
DEV int opaque_tid() { int t = threadIdx.x; asm volatile("" : "+v"(t)); return t; }
DEV float bf2f(bf16 v) { return __uint_as_float((unsigned)v << 16); }
DEV float bflo(unsigned u) { return __uint_as_float(u << 16); }
DEV float bfhi(unsigned u) { return __uint_as_float(u & 0xffff0000u); }
DEV unsigned f2bf(float f) { unsigned u = __float_as_uint(f); return (u + 0x7fffu + ((u >> 16) & 1u)) >> 16; }
DEV unsigned pk2(float lo, float hi) { return f2bf(lo) | (f2bf(hi) << 16); }
DEV float wave_sum(float v) {
#pragma unroll
    for (int o = 1; o < 64; o <<= 1) v += __shfl_xor(v, o);
    return v;
}
DEV float wave_max(float v) {
#pragma unroll
    for (int o = 1; o < 64; o <<= 1) v = fmaxf(v, __shfl_xor(v, o));
    return v;
}
DEV float silu_f(float x) { return x / (1.f + __expf(-x)); }
DEV float log_sigmoid_f(float x) { return fminf(x, 0.f) - log1pf(__expf(-fabsf(x))); }
DEV void moe_rowbase(const unsigned* cnt, int* rb  ) { int a = 0; for (int e = 0; e < NEXP; ++e) { rb[e] = a; a += ((int)cnt[e] + 255) & ~255; } rb[NEXP] = a; }

DEV void phase_prologue(const Params& P, unsigned char* lds, int vb, int nvb, bool with_weights) {
    const int tid = opaque_tid(), lane = tid & 63, wave = tid >> 6;
    float* cond = (float*)lds;
    float* red = (float*)(lds + 32768);
    const float* c = P.in[I_C];
    for (int i = tid; i < NBATCH * DM; i += 512) cond[i] = silu_f(c[i]);
    __syncthreads();
    float* MOD = (float*)(P.ws + WS_MOD);
    const float* adaw = P.in[I_ADAW]; const float* adab = P.in[I_ADAB];
    for (int u = vb; u < DEPTH * 96; u += nvb) {
        const int l = u / 96, col = (u % 96) * 64 + lane;
        float acc[8];
#pragma unroll
        for (int b = 0; b < 8; ++b) acc[b] = 0.f;
        const float* wp = adaw + ((size_t)l * DM + wave * 128) * (6 * DM) + col;
#pragma unroll 4
        for (int k = 0; k < 128; ++k) {
            const float w = wp[(size_t)k * (6 * DM)];
#pragma unroll
            for (int b = 0; b < 8; ++b) acc[b] += cond[b * DM + wave * 128 + k] * w;
        }
#pragma unroll
        for (int b = 0; b < 8; ++b) red[(wave * 8 + b) * 64 + lane] = acc[b];
        __syncthreads();
        {
            float s = 0.f;
#pragma unroll
            for (int w = 0; w < 8; ++w) s += red[(w * 8 + wave) * 64 + lane];
            MOD[((size_t)l * NBATCH + wave) * (6 * DM) + col] = s + adab[(size_t)l * 6 * DM + col];
        }
        __syncthreads();
    }
    if (vb == 0) {
        float* BT = (float*)(P.ws + WS_BT); const float* rb = P.in[I_RELB];
        for (int i = tid; i < 8 * 128; i += 512) { const int h = i >> 7, d = i & 127; BT[i] = rb[REL_BUCKET[d] * 8 + h]; }
    }
    if (!with_weights) return;
    float* scr = (float*)(lds + 49152 + wave * 8448);
    constexpr int IT_EI = 2 * 16 * 72, IT_EO = 2 * 16 * 32, IT_OI = 2 * 16 * 96, IT_OO = 2 * 16 * 32, IT_W = DEPTH * NEXP * 256;
    constexpr int NITEMS = IT_EI + IT_EO + IT_OI + IT_OO + 3 * IT_W;
    for (int it = vb * 8 + wave; it < NITEMS; it += nvb * 8) {
        int r = it; const float* W; int ldw, k0, n0, K = DM, drow0; bf16* WT;
        if (r < IT_EI) { const int jl = r / 1152, rr = r % 1152; k0 = (rr / 72) * 64; n0 = (rr % 72) * 32; W = P.in[I_EWIN] + (size_t)jl * DM * EVEN_IN; ldw = EVEN_IN; WT = (bf16*)(P.ws + WS_WEI) + (size_t)jl * EVN * DM; drow0 = n0; }
        else if ((r -= IT_EI) < IT_EO) { const int jl = r / 512, rr = r % 512; k0 = (rr / 32) * 64; n0 = (rr % 32) * 32; W = P.in[I_EWOUT] + (size_t)jl * DM * DM; ldw = DM; WT = (bf16*)(P.ws + WS_WEO) + (size_t)jl * DM * DM; drow0 = n0; }
        else if ((r -= IT_EO) < IT_OI) { const int jl = r / 1536, rr = r % 1536; k0 = (rr / 96) * 64; n0 = (rr % 96) * 32; W = P.in[I_OWIN] + (size_t)jl * DM * ODN; ldw = ODN; WT = (bf16*)(P.ws + WS_WOI) + (size_t)jl * ODN * DM; drow0 = n0; }
        else if ((r -= IT_OI) < IT_OO) { const int jl = r / 512, rr = r % 512; k0 = (rr / 32) * 64; n0 = (rr % 32) * 32; W = P.in[I_OWOUT] + (size_t)jl * DM * DM; ldw = DM; WT = (bf16*)(P.ws + WS_WOO) + (size_t)jl * DM * DM; drow0 = n0; }
        else if ((r -= IT_OO) < 2 * IT_W) { const int w3 = r >= IT_W; if (w3) r -= IT_W; const int le = r >> 8, rr = r & 255; k0 = (rr >> 4) * 64; n0 = (rr & 15) * 32;
            W = P.in[w3 ? I_MW3 : I_MW1] + (size_t)le * DM * MOEH; ldw = MOEH; WT = (bf16*)(P.ws + WS_WUP) + (size_t)le * 1024 * DM; drow0 = (n0 >> 7) * 256 + (n0 & 127) + (w3 ? 128 : 0); }
        else { r -= 2 * IT_W; const int le = r >> 8, rr = r & 255; k0 = (rr >> 5) * 64; n0 = (rr & 31) * 32; W = P.in[I_MW2] + (size_t)le * MOEH * DM; ldw = DM; K = MOEH; WT = (bf16*)(P.ws + WS_WDN) + (size_t)le * DM * MOEH; drow0 = n0; }
#pragma unroll 8
        for (int i = 0; i < 32; ++i) { const int kk = 2 * i + (lane >> 5); scr[kk * 33 + (lane & 31)] = W[(size_t)(k0 + kk) * ldw + n0 + (lane & 31)]; }
        asm volatile("s_waitcnt lgkmcnt(0)" ::: "memory");
        const int c = lane & 7;
#pragma unroll
        for (int j = 0; j < 4; ++j) { const int n = (lane >> 3) + 8 * j; const float* s = scr + (8 * c) * 33 + n;
            u32x4 o; o.x = pk2(s[0 * 33], s[1 * 33]); o.y = pk2(s[2 * 33], s[3 * 33]); o.z = pk2(s[4 * 33], s[5 * 33]); o.w = pk2(s[6 * 33], s[7 * 33]);
            *(u32x4*)(WT + (size_t)(drow0 + n) * K + k0 + 8 * c) = o; }
        asm volatile("s_waitcnt lgkmcnt(0)" ::: "memory");
    }
}

constexpr int NT_TS = 1028;
constexpr int NT_MISC = 148480;
DEV float rs16(const float (&a)[16], int lane) {
    float b8[8], b4[4], b2[2];
    const bool u32_ = lane & 32, u16_ = lane & 16, u8_ = lane & 8, u4_ = lane & 4;
#pragma unroll
    for (int i = 0; i < 8; ++i) { const float keep = u32_ ? a[8 + i] : a[i], send = u32_ ? a[i] : a[8 + i]; b8[i] = keep + __shfl_xor(send, 32); }
#pragma unroll
    for (int i = 0; i < 4; ++i) { const float keep = u16_ ? b8[4 + i] : b8[i], send = u16_ ? b8[i] : b8[4 + i]; b4[i] = keep + __shfl_xor(send, 16); }
#pragma unroll
    for (int i = 0; i < 2; ++i) { const float keep = u8_ ? b4[2 + i] : b4[i], send = u8_ ? b4[i] : b4[2 + i]; b2[i] = keep + __shfl_xor(send, 8); }
    float r = (u4_ ? b2[1] : b2[0]) + __shfl_xor(u4_ ? b2[0] : b2[1], 4);
    r += __shfl_xor(r, 1); r += __shfl_xor(r, 2);
    return r;
}
DEV void phase_norm(const Params& P, unsigned char* lds, int vb, int nvb, int mode, int layer, const float* xsrc, float* xdst, int clayer  , int dry = 0) {
    const int tid = opaque_tid(), lane = tid & 63, wave = tid >> 6;
    float* tab = (float*)lds;
    int* lcnt = (int*)(lds + NT_MISC);
    int* lbase = lcnt + 32;
    int* rowb = lbase + 32;
    int* plist = rowb + 64;
    int* pn = plist + 512;
    const unsigned* ctl = (const unsigned*)(P.ws + WS_CTL);
    float* MOD = (float*)(P.ws + WS_MOD);
    if (mode == 1) { const float* w = P.in[I_EWIN] + (size_t)(layer >> 1) * DM * EVEN_IN;
        for (int i = tid; i < DM * 16; i += 512) { const int k = i >> 4, j = i & 15; tab[j * NT_TS + k] = w[(size_t)k * EVEN_IN + EVN + j]; } }
    if (mode == 3) { const float* wg = P.in[I_MWG] + (size_t)layer * DM * 4; const float* we = P.in[I_MWE] + (size_t)layer * DM * 32;
        for (int i = tid; i < DM * 4; i += 512) { const int k = i >> 2, j = i & 3; tab[j * NT_TS + k] = wg[i]; }
        for (int i = tid; i < DM * 32; i += 512) { const int k = i >> 5, j = i & 31; tab[(4 + j) * NT_TS + k] = we[i]; }
        if (tid < 32) lcnt[tid] = 0; if (tid == 0) pn[0] = 0; }
    if (clayer >= 0 && tid == 0) moe_rowbase(ctl + CW_CNT + clayer * 32, rowb);
    __syncthreads();
    const int* PE = (const int*)(P.ws + WS_PAIRE); const int* PS = (const int*)(P.ws + WS_PAIRS); const float* PG = (const float*)(P.ws + WS_PAIRG);
    const bf16* YP = (const bf16*)(P.ws + WS_YP);
    bf16* H = (bf16*)(P.ws + WS_H);
    const int NQ = (mode == 1) ? 16 : 36;
    for (int p = vb * 8 + wave; p < NTOK / 2; p += nvb * 8) {
        const int b = (2 * p) >> 12;
        f32x4 v[2][4];
#pragma unroll
        for (int rr = 0; rr < 2; ++rr)
#pragma unroll
            for (int j = 0; j < 4; ++j) v[rr][j] = *(const f32x4*)(xsrc + (size_t)(2 * p + rr) * DM + j * 256 + lane * 4);
        if (clayer >= 0) {
            const float* gate2 = MOD + ((size_t)clayer * NBATCH + b) * (6 * DM) + 5 * DM;
#pragma unroll
            for (int rr = 0; rr < 2; ++rr) { const int r = 2 * p + rr;
                const int e0 = PE[2 * r], e1 = PE[2 * r + 1]; const float g0 = PG[2 * r], g1 = PG[2 * r + 1];
                const size_t p0 = (size_t)(rowb[e0] + PS[2 * r]), p1 = (size_t)(rowb[e1] + PS[2 * r + 1]);
#pragma unroll
                for (int j = 0; j < 4; ++j) {
                    const u32x2 y0 = *(const u32x2*)(YP + p0 * DM + j * 256 + lane * 4), y1 = *(const u32x2*)(YP + p1 * DM + j * 256 + lane * 4);
                    const f32x4 g = *(const f32x4*)(gate2 + j * 256 + lane * 4);
                    f32x4 m;
                    m.x = g0 * bflo(y0.x) + g1 * bflo(y1.x); m.y = g0 * bfhi(y0.x) + g1 * bfhi(y1.x);
                    m.z = g0 * bflo(y0.y) + g1 * bflo(y1.y); m.w = g0 * bfhi(y0.y) + g1 * bfhi(y1.y);
                    v[rr][j] = v[rr][j] + g * m;
                    if (xdst && !dry) *(f32x4*)(xdst + (size_t)r * DM + j * 256 + lane * 4) = v[rr][j];
                } }
        }
        if (mode == 0) continue;
        const float* nw = P.in[mode == 3 ? I_N2W : I_N1W] + (size_t)layer * DM;
        const float* modr = MOD + ((size_t)layer * NBATCH + b) * (6 * DM) + (mode == 3 ? 3 * DM : 0);
#pragma unroll
        for (int rr = 0; rr < 2; ++rr) {
            float ss = 0.f;
#pragma unroll
            for (int j = 0; j < 4; ++j) ss += (v[rr][j].x * v[rr][j].x + v[rr][j].y * v[rr][j].y) + (v[rr][j].z * v[rr][j].z + v[rr][j].w * v[rr][j].w);
            const float rstd = rsqrtf(wave_sum(ss) * (1.f / DM) + RMS_EPS);
#pragma unroll
            for (int j = 0; j < 4; ++j) {
                const int c0 = j * 256 + lane * 4;
                const f32x4 w = *(const f32x4*)(nw + c0), sh = *(const f32x4*)(modr + c0), sc = *(const f32x4*)(modr + DM + c0);
                v[rr][j] = (v[rr][j] * rstd * w) * (sc + 1.f) + sh;
                u32x2 o; o.x = pk2(v[rr][j].x, v[rr][j].y); o.y = pk2(v[rr][j].z, v[rr][j].w);
                if (!dry) *(u32x2*)(H + (size_t)(2 * p + rr) * DM + c0) = o;
            }
        }
        if (mode == 2) continue;
        float val[5];
#pragma unroll
        for (int gq = 0; gq < 5; ++gq) {
            val[gq] = 0.f;
            if (gq * 8 < NQ) {
                float acc[16];
#pragma unroll
                for (int i = 0; i < 8; ++i) { const int q = gq * 8 + i; acc[i] = 0.f; acc[8 + i] = 0.f;
                    if (q < 36 && q < NQ) {
                        f32x4 s0 = (f32x4){0.f, 0.f, 0.f, 0.f}, s1 = s0;
#pragma unroll
                        for (int j = 0; j < 4; ++j) { const f32x4 t = *(const f32x4*)(tab + q * NT_TS + j * 256 + lane * 4); s0 += v[0][j] * t; s1 += v[1][j] * t; }
                        acc[i] = (s0.x + s0.y) + (s0.z + s0.w); acc[8 + i] = (s1.x + s1.y) + (s1.z + s1.w); }
                    if (i & 1) __builtin_amdgcn_sched_barrier(0); }
                val[gq] = rs16(acc, lane);
            }
        }
        const int rowsel = lane >> 5, r = 2 * p + rowsel, sub = (lane >> 2) & 7;
        if (mode == 1) {
            if ((lane & 3) == 0 && !dry) { float* ab = (float*)(P.ws + WS_AB) + (size_t)r * 16; ab[sub] = val[0]; ab[8 + sub] = val[1]; }
            continue;
        }
        {
            const int rb32 = rowsel * 32;
            const float* bg = P.in[I_MBG] + layer * 4; const float* be = P.in[I_MBE] + layer * 32;
            float gl[4];
#pragma unroll
            for (int i = 0; i < 4; ++i) gl[i] = __shfl(val[0], rb32 + 4 * i) + bg[i];
            int g = 0; float gm = gl[0];
#pragma unroll
            for (int i = 1; i < 4; ++i) if (gl[i] > gm) { gm = gl[i]; g = i; }
            float den = 0.f;
#pragma unroll
            for (int i = 0; i < 4; ++i) den += __expf(gl[i] - gm);
            const float pg = 1.f / den;
            const float va = g == 0 ? val[0] : (g == 1 ? val[1] : (g == 2 ? val[2] : val[3]));
            const float vbb = g == 0 ? val[1] : (g == 1 ? val[2] : (g == 2 ? val[3] : val[4]));
            float el[8];
#pragma unroll
            for (int i = 0; i < 8; ++i) el[i] = __shfl(i < 4 ? va : vbb, rb32 + 4 * ((4 + i) & 7)) + be[g * 8 + i];
            int i1 = 0; float v1 = el[0];
#pragma unroll
            for (int i = 1; i < 8; ++i) if (el[i] > v1) { v1 = el[i]; i1 = i; }
            int i2 = -1; float v2 = -INFINITY;
#pragma unroll
            for (int i = 0; i < 8; ++i) if (i != i1 && el[i] > v2) { v2 = el[i]; i2 = i; }
            const float t2 = __expf(v2 - v1), w1 = 1.f / (1.f + t2), w2 = t2 * w1;
            if ((lane & 31) == 0 && !dry) {
                const int ea = g * 8 + i1, eb = g * 8 + i2;
                int* PEw = (int*)(P.ws + WS_PAIRE); float* PGw = (float*)(P.ws + WS_PAIRG);
                PEw[2 * r] = ea; PEw[2 * r + 1] = eb; PGw[2 * r] = pg * w1; PGw[2 * r + 1] = pg * w2;
                const int sa = atomicAdd(&lcnt[ea], 1), sb = atomicAdd(&lcnt[eb], 1);
                const int ix = atomicAdd(&pn[0], 2);
                plist[2 * ix] = 2 * r; plist[2 * ix + 1] = (ea << 16) | sa; plist[2 * ix + 2] = 2 * r + 1; plist[2 * ix + 3] = (eb << 16) | sb;
            }
        }
    }
    if (mode == 3 && !dry) {
        __syncthreads();
        unsigned* cnt = (unsigned*)(P.ws + WS_CTL) + CW_CNT + layer * 32;
        if (tid < 32) lbase[tid] = (int)__hip_atomic_fetch_add(cnt + tid, (unsigned)lcnt[tid], __ATOMIC_RELAXED, __HIP_MEMORY_SCOPE_AGENT);
        __syncthreads();
        int* LIST = (int*)(P.ws + WS_LIST); int* PSw = (int*)(P.ws + WS_PAIRS);
        const int n = pn[0];
        for (int i = tid; i < n; i += 512) { const int pair = plist[2 * i], es = plist[2 * i + 1], e = es >> 16, slot = lbase[e] + (es & 0xffff);
            LIST[(size_t)e * NTOK + slot] = pair; PSw[pair] = slot; }
    }
    __syncthreads();
}

DEV void phase_kprep(const Params& P, unsigned char* lds, int vb, int nvb, int layer, int dry = 0) {
    const int tid = opaque_tid(), lane = tid & 63, wave = tid >> 6;
    float* red = (float*)lds;
    bf16* QKV = (bf16*)(P.ws + WS_BIG); float* KM = (float*)(P.ws + WS_KMEAN);
    const float* kn = P.in[I_CKN] + (layer >> 1) * 128;
    const float w0 = kn[2 * lane], w1 = kn[2 * lane + 1];
    for (int u = vb; u < NBATCH * 16 * 8; u += nvb) {
        const int h = u & 7, j = (u >> 3) & 15, b = u >> 7;
        float m0 = 0.f, m1 = 0.f;
        for (int i = 0; i < 32; ++i) {
            unsigned* p = (unsigned*)(QKV + ((size_t)b * SEQ + j * 256 + wave * 32 + i) * ODN + 1024 + h * 128 + 2 * lane);
            const unsigned uu = *p; float k0 = bflo(uu), k1 = bfhi(uu);
            const float rs = rsqrtf(wave_sum(k0 * k0 + k1 * k1) * (1.f / 128.f) + RMS_EPS);
            k0 *= rs * w0; k1 *= rs * w1; m0 += k0; m1 += k1;
            if (!dry) *p = pk2(k0, k1);
        }
        red[wave * 128 + 2 * lane] = m0; red[wave * 128 + 2 * lane + 1] = m1;
        __syncthreads();
        if (tid < 128) { float s = 0.f;
#pragma unroll
            for (int w = 0; w < 8; ++w) s += red[w * 128 + tid];
            if (!dry) KM[(((size_t)b * 16 + j) * 8 + h) * 128 + tid] = s * (1.f / 256.f); }
        __syncthreads();
    }
}

__global__ void __launch_bounds__(512) k_prologue(Params P) { extern __shared__ __attribute__((aligned(16))) unsigned char lds[]; phase_prologue(P, lds, blockIdx.x, gridDim.x, false); }
__global__ void __launch_bounds__(512) k_norm(Params P, int mode, int layer, const float* xsrc, float* xdst, int clayer) {
    extern __shared__ __attribute__((aligned(16))) unsigned char lds[]; phase_norm(P, lds, blockIdx.x, gridDim.x, mode, layer, xsrc, xdst, clayer); }
__global__ void __launch_bounds__(512) k_kprep(Params P, int layer) { extern __shared__ __attribute__((aligned(16))) unsigned char lds[]; phase_kprep(P, lds, blockIdx.x, gridDim.x, layer); }

namespace pg8 {
#define PG8_LAS __attribute__((address_space(3)))
typedef unsigned short bf16_t;
typedef short bf16x8 __attribute__((ext_vector_type(8)));
constexpr int BM = 256, BK = 64, HALF = 128, HTB = HALF * BK * 2  , STAGE_BYTES = 8 * HTB, NXCD = 8, WGM = 8;
__host__ __device__ __forceinline__ int lds_byte(int r, int c) { const int st = (r >> 4) * 2 + (c >> 5), rr = r & 15, cc = c & 31, ob = rr * 64 + cc * 2; return st * 1024 + (ob ^ (((ob >> 9) & 1) << 5)); }
__host__ __device__ __forceinline__ void stage_rc(int b, int& R, int& C) { const int st = b / 1024, sb = b % 1024, swz = sb ^ (((sb >> 9) & 1) << 5); R = (st >> 1) * 16 + swz / 64; C = (st & 1) * 32 + (swz % 64) / 2; }
__host__ __device__ __forceinline__ int perm32(int rho) { const int n = rho >> 4, i = rho & 15; return 8 * (i >> 2) + 4 * n + (i & 3); }

struct Unit { int pm, pn, bsel, aux; };
struct Gemm { const bf16_t* A; const bf16_t* Bt; int K; size_t bstride; };

struct StaticOrder {
    static constexpr bool GATHER = false;
    PG8_LAS int* tokl; int nM, nN, nwg, G, c;
    __device__ void init(int M, int N, int G_, int c_) { nM = M / BM; nN = N / BM; nwg = nM * nN; G = G_; c = c_; }
    __device__ bool next(int i, Unit& u) const {
        const long L = (long)i * G + c; if (L >= nwg) return false;
        int wgid = (int)L; { const int q = nwg / NXCD, r = nwg % NXCD, xcd = wgid % NXCD, off = wgid / NXCD; wgid = (xcd < r ? xcd * (q + 1) : r * (q + 1) + (xcd - r) * q) + off; }
        const int nig = WGM * nN, gid = wgid / nig, fm = gid * WGM, gsz = (nM - fm) < WGM ? (nM - fm) : WGM;
        u.pm = fm + ((wgid % nig) % gsz); u.pn = (wgid % nig) / gsz; u.bsel = 0; u.aux = 0; return true;
    }
    __device__ __forceinline__ int src_row(const Unit&, int) const { return 0; }
};
template <bool GATHER_> struct MoeOrder {
    static constexpr bool GATHER = GATHER_;
    const PG8_LAS int* tp; const PG8_LAS unsigned* cnt; const int* list; PG8_LAS int* tokl; int nN, G, c;
    __device__ bool next(int i, Unit& u) const {
        const int L = i * G + c; const int rt = L / nN; if (rt >= tp[NEXP]) return false;
        int e = 0;
#pragma unroll 1
        for (int k = 1; k < NEXP; ++k) e = (rt >= tp[k]) ? k : e;
        u.pm = rt; u.pn = L - rt * nN; u.bsel = e; u.aux = rt - tp[e]; return true;
    }
    __device__ __forceinline__ int src_row(const Unit& u, int r) const { const int s = u.aux * BM + r; return s < (int)cnt[u.bsel] ? (list[(size_t)u.bsel * NTOK + s] >> 1) : 0; }
};

__device__ __forceinline__ unsigned cvt_pk_bf16(float lo, float hi) { unsigned r; asm volatile("v_cvt_pk_bf16_f32 %0, %1, %2" : "=v"(r) : "v"(lo), "v"(hi)); return r; }
struct EpiBf16 {
    static constexpr bool PERM = true;
    bf16_t* O; int ldc;
    __device__ __forceinline__ void operator()(const f32x4 (&acc)[2][2][4][2], const Unit& u, int wr, int wc, int fr, int fq) const {
        const int row0 = u.pm * BM + wr * 64 + fr, col0 = u.pn * BM + wc * 32 + 8 * fq;
#pragma unroll
        for (int ai = 0; ai < 2; ++ai)
#pragma unroll
            for (int m = 0; m < 4; ++m) { bf16_t* rowp = O + (size_t)(row0 + ai * HALF + m * 16) * ldc + col0;
#pragma unroll
                for (int bj = 0; bj < 2; ++bj) { const f32x4 v0 = acc[ai][bj][m][0], v1 = acc[ai][bj][m][1];
                    u32x4 w; w.x = cvt_pk_bf16(v0[0], v0[1]); w.y = cvt_pk_bf16(v0[2], v0[3]); w.z = cvt_pk_bf16(v1[0], v1[1]); w.w = cvt_pk_bf16(v1[2], v1[3]);
                    *(u32x4*)(rowp + bj * HALF) = w; } }
    }
};
struct EpiQKV {
    static constexpr bool PERM = true;
    bf16_t* O; int ldc; int odd; const float* kw; float* KM; PG8_LAS float* xl;
    __device__ __forceinline__ void operator()(const f32x4 (&acc)[2][2][4][2], const Unit& u, int wr, int wc, int fr, int fq) const {
        const int row0 = u.pm * BM + wr * 64 + fr, col0 = u.pn * BM + wc * 32 + 8 * fq;
        const bool isK = odd && u.pn >= 4 && u.pn < 8;
        if (!isK) {
#pragma unroll
            for (int ai = 0; ai < 2; ++ai)
#pragma unroll
                for (int m = 0; m < 4; ++m) { bf16_t* rowp = O + (size_t)(row0 + ai * HALF + m * 16) * ldc + col0;
#pragma unroll
                    for (int bj = 0; bj < 2; ++bj) { const f32x4 v0 = acc[ai][bj][m][0], v1 = acc[ai][bj][m][1];
                        u32x4 w; w.x = cvt_pk_bf16(v0[0], v0[1]); w.y = cvt_pk_bf16(v0[2], v0[3]); w.z = cvt_pk_bf16(v1[0], v1[1]); w.w = cvt_pk_bf16(v1[2], v1[3]);
                        *(u32x4*)(rowp + bj * HALF) = w; } }
            return;
        }
#pragma unroll
        for (int ai = 0; ai < 2; ++ai)
#pragma unroll
            for (int m = 0; m < 4; ++m)
#pragma unroll
                for (int bj = 0; bj < 2; ++bj) { const f32x4 a = acc[ai][bj][m][0], b = acc[ai][bj][m][1];
                    float s = (a[0] * a[0] + a[1] * a[1]) + (a[2] * a[2] + a[3] * a[3]) + (b[0] * b[0] + b[1] * b[1]) + (b[2] * b[2] + b[3] * b[3]);
                    s += __shfl_xor(s, 16); s += __shfl_xor(s, 32);
                    if (fq == 0) xl[((ai * HALF + wr * 64 + m * 16 + fr) * 2 + bj) * 4 + wc] = s; }
        asm volatile("s_waitcnt lgkmcnt(0)" ::: "memory"); __builtin_amdgcn_s_barrier(); asm volatile("" ::: "memory");
        const f32x4 w0 = *(const f32x4*)(kw + wc * 32 + 8 * fq), w1 = *(const f32x4*)(kw + wc * 32 + 8 * fq + 4);
        f32x4 cs[2][2];
#pragma unroll
        for (int bj = 0; bj < 2; ++bj) { cs[bj][0] = (f32x4){0.f, 0.f, 0.f, 0.f}; cs[bj][1] = cs[bj][0]; }
#pragma unroll
        for (int ai = 0; ai < 2; ++ai)
#pragma unroll
            for (int m = 0; m < 4; ++m) { const int rl = ai * HALF + wr * 64 + m * 16 + fr; bf16_t* rowp = O + (size_t)(u.pm * BM + rl) * ldc + col0;
#pragma unroll
                for (int bj = 0; bj < 2; ++bj) { const f32x4 t = *(const PG8_LAS f32x4*)(xl + (rl * 2 + bj) * 4);
                    const float rs = rsqrtf(((t[0] + t[1]) + (t[2] + t[3])) * (1.f / 128.f) + RMS_EPS);
                    const f32x4 v0 = acc[ai][bj][m][0] * rs * w0, v1 = acc[ai][bj][m][1] * rs * w1;
                    cs[bj][0] += v0; cs[bj][1] += v1;
                    u32x4 w; w.x = cvt_pk_bf16(v0[0], v0[1]); w.y = cvt_pk_bf16(v0[2], v0[3]); w.z = cvt_pk_bf16(v1[0], v1[1]); w.w = cvt_pk_bf16(v1[2], v1[3]);
                    *(u32x4*)(rowp + bj * HALF) = w; }
                __builtin_amdgcn_sched_barrier(0); }
        PG8_LAS float* x2 = xl + 2048;
#pragma unroll
        for (int bj = 0; bj < 2; ++bj)
#pragma unroll
            for (int n = 0; n < 2; ++n)
#pragma unroll
                for (int j = 0; j < 4; ++j) { float c = cs[bj][n][j]; c += __shfl_xor(c, 1); c += __shfl_xor(c, 2); c += __shfl_xor(c, 4); c += __shfl_xor(c, 8);
                    if (fr == 0) x2[(wr * 2 + bj) * 128 + wc * 32 + 8 * fq + 4 * n + j] = c; }
        asm volatile("s_waitcnt lgkmcnt(0)" ::: "memory"); __builtin_amdgcn_s_barrier(); asm volatile("" ::: "memory");
        { const int t = (wr * 4 + wc) * 64 + fq * 16 + fr; if (t < 256) { const int bj = t >> 7, d = t & 127;
            KM[((((size_t)(u.pm >> 4)) * 16 + (u.pm & 15)) * 8 + (u.pn - 4) * 2 + bj) * 128 + d] = (x2[bj * 128 + d] + x2[(2 + bj) * 128 + d]) * (1.f / 256.f); } }
    }
};
struct EpiResid {
    static constexpr bool PERM = false;
    const float* xin; float* xout; const float* gate; int dry;
    __device__ __forceinline__ void operator()(const f32x4 (&acc)[2][2][4][2], const Unit& u, int wr, int wc, int fr, int fq) const {
        const int row0 = u.pm * BM + wr * 64 + fr, col0 = u.pn * BM + wc * 32 + 4 * fq;
        const float* gr = gate + (size_t)((u.pm * BM) >> 12) * (6 * DM) + col0;
        f32x4 gv[2][2];
#pragma unroll
        for (int bj = 0; bj < 2; ++bj)
#pragma unroll
            for (int n = 0; n < 2; ++n) gv[bj][n] = *(const f32x4*)(gr + bj * HALF + n * 16);
#pragma unroll
        for (int ai = 0; ai < 2; ++ai)
#pragma unroll
            for (int m = 0; m < 4; ++m) { const size_t off = (size_t)(row0 + ai * HALF + m * 16) * DM + col0;
#pragma unroll
                for (int bj = 0; bj < 2; ++bj)
#pragma unroll
                    for (int n = 0; n < 2; ++n) { const f32x4 xi = *(const f32x4*)(xin + off + bj * HALF + n * 16); const f32x4 ov = xi + gv[bj][n] * acc[ai][bj][m][n]; if (!dry) *(f32x4*)(xout + off + bj * HALF + n * 16) = ov; } }
    }
};
struct EpiSiluMul {
    static constexpr bool PERM = true;
    bf16_t* O;
    __device__ __forceinline__ void operator()(const f32x4 (&acc)[2][2][4][2], const Unit& u, int wr, int wc, int fr, int fq) const {
        const int row0 = u.pm * BM + wr * 64 + fr, col0 = u.pn * HALF + wc * 32 + 8 * fq;
#pragma unroll
        for (int ai = 0; ai < 2; ++ai)
#pragma unroll
            for (int m = 0; m < 4; ++m) { bf16_t* rowp = O + (size_t)(row0 + ai * HALF + m * 16) * MOEH + col0;
                float o[8];
#pragma unroll
                for (int n = 0; n < 2; ++n)
#pragma unroll
                    for (int j = 0; j < 4; ++j) { const float a = acc[ai][0][m][n][j], b = acc[ai][1][m][n][j]; o[n * 4 + j] = a * __builtin_amdgcn_rcpf(1.f + __expf(-a)) * b; }
                u32x4 w; w.x = cvt_pk_bf16(o[0], o[1]); w.y = cvt_pk_bf16(o[2], o[3]); w.z = cvt_pk_bf16(o[4], o[5]); w.w = cvt_pk_bf16(o[6], o[7]);
                *(u32x4*)rowp = w; }
    }
};

template <class Epi, class Sched>
__device__ __forceinline__ void gemm_phase(PG8_LAS unsigned char* lds, const Gemm g, const Sched& S, const Epi& E) {
    constexpr bool GA = Sched::GATHER;
    const int tid = opaque_tid(), wid = __builtin_amdgcn_readfirstlane(tid >> 6), lane = tid & 63, wr = wid >> 2, wc = wid & 3, fr = lane & 15, fq = lane >> 4;
    const int K = g.K, nt = K / BK;
    const size_t kstep = (size_t)(BK * 2);
    const size_t hstep = (size_t)HALF * K * 2;
    const size_t tstep = 2 * hstep;
    unsigned voffB[2]; int RA[2], CA[2];
#pragma unroll
    for (int i = 0; i < 2; ++i) { int R, C; stage_rc(tid * 16 + i * 8192, R, C); const int Rb = Epi::PERM ? ((R & ~31) + perm32(R & 31)) : R;
        RA[i] = R; CA[i] = C; voffB[i] = (unsigned)(Rb * K + C) * 2u; }
    const unsigned ldsw = (unsigned)wid * 1024u;
    const int aoff = lds_byte(wr * 64 + fr, fq * 8), boff = lds_byte(wc * 32 + fr, fq * 8);
#define PG8_SA(b, h) (((b) * 2 + (h)) * HTB)
#define PG8_SB(b, h) ((4 + (b) * 2 + (h)) * HTB)
#define PG8_STAGE2(bufoff, gbase, o0, o1) do { \
        __builtin_amdgcn_global_load_lds((const unsigned*)((const char*)(gbase) + (o0)), (PG8_LAS unsigned*)(lds + (bufoff) + ldsw), 16, 0, 0); \
        __builtin_amdgcn_global_load_lds((const unsigned*)((const char*)(gbase) + (o1)), (PG8_LAS unsigned*)(lds + (bufoff) + ldsw + 8192), 16, 0, 0); } while (0)
#define PG8_STAGEB(bufoff, gbase) PG8_STAGE2(bufoff, gbase, voffB[0], voffB[1])
#define PG8_LDA(dst, b, h) do { _Pragma("unroll") for (int m = 0; m < 4; ++m) _Pragma("unroll") for (int k = 0; k < 2; ++k) dst[m][k] = *(const PG8_LAS bf16x8*)(lds + PG8_SA(b, h) + aoff + m * 2048 + k * 1024); } while (0)
#define PG8_LDB(dst, b, h) do { _Pragma("unroll") for (int n = 0; n < 2; ++n) _Pragma("unroll") for (int k = 0; k < 2; ++k) dst[n][k] = *(const PG8_LAS bf16x8*)(lds + PG8_SB(b, h) + boff + n * 2048 + k * 1024); } while (0)
#define PG8_MMA(ai, bj, At, Bt) do { __builtin_amdgcn_s_setprio(1); _Pragma("unroll") for (int m = 0; m < 4; ++m) _Pragma("unroll") for (int n = 0; n < 2; ++n) _Pragma("unroll") for (int k = 0; k < 2; ++k) \
        acc[ai][bj][m][n] = __builtin_amdgcn_mfma_f32_16x16x32_bf16(Bt[n][k], At[m][k], acc[ai][bj][m][n], 0, 0, 0); __builtin_amdgcn_s_setprio(0); } while (0)
#define PG8_WAIT_V(n) asm volatile("s_waitcnt vmcnt(" #n ")" ::: "memory")
#define PG8_WAIT_L(n) asm volatile("s_waitcnt lgkmcnt(" #n ")" ::: "memory")
#define PG8_BAR __builtin_amdgcn_s_barrier()
#define PG8_SCHED __builtin_amdgcn_sched_barrier(0)
    Unit cur, nxt; int ui = 0;
    if (!S.next(0, cur)) return;
    f32x4 acc[2][2][4][2];
#pragma unroll
    for (int a = 0; a < 2; ++a)
#pragma unroll
        for (int b = 0; b < 2; ++b)
#pragma unroll
            for (int m = 0; m < 4; ++m)
#pragma unroll
                for (int n = 0; n < 2; ++n) acc[a][b][m][n] = (f32x4){0.f, 0.f, 0.f, 0.f};
    bf16x8 At[4][2], B0[2][2], B1[2][2];
    unsigned vA[2][2];
    if constexpr (GA) {
        if (tid < BM) S.tokl[tid] = S.src_row(cur, tid);
        asm volatile("s_waitcnt vmcnt(0) lgkmcnt(0)" ::: "memory"); __builtin_amdgcn_s_barrier(); asm volatile("" ::: "memory");
#pragma unroll
        for (int h = 0; h < 2; ++h)
#pragma unroll
            for (int i = 0; i < 2; ++i) vA[h][i] = (unsigned)(S.tokl[h * HALF + RA[i]] * K + CA[i]) * 2u;
    } else {
#pragma unroll
        for (int h = 0; h < 2; ++h)
#pragma unroll
            for (int i = 0; i < 2; ++i) vA[h][i] = (unsigned)(RA[i] * K + CA[i]) * 2u;
    }
    const size_t ah = GA ? (size_t)0 : hstep;
    const char* cA = GA ? (const char*)g.A : (const char*)g.A + (size_t)cur.pm * tstep;
    const char* cB = (const char*)(g.Bt + (size_t)cur.bsel * g.bstride) + (size_t)cur.pn * tstep;
    PG8_STAGEB(PG8_SB(0, 0), cB); PG8_STAGEB(PG8_SB(0, 1), cB + hstep); PG8_STAGE2(PG8_SA(0, 0), cA, vA[0][0], vA[0][1]); PG8_STAGE2(PG8_SA(0, 1), cA + ah, vA[1][0], vA[1][1]);
    if (wr == 1) PG8_BAR;
    PG8_WAIT_V(2); PG8_BAR;
    PG8_STAGEB(PG8_SB(1, 0), cB + kstep); PG8_STAGE2(PG8_SA(1, 0), cA + kstep, vA[0][0], vA[0][1]); PG8_STAGEB(PG8_SB(1, 1), cB + hstep + kstep);
    PG8_WAIT_V(6); PG8_BAR;
    for (;;) {
        const bool has_next = S.next(ui + 1, nxt);
        if constexpr (GA) { if (has_next && tid < BM) S.tokl[tid] = S.src_row(nxt, tid); }
        const char* nA = GA ? cA : (has_next ? (const char*)g.A + (size_t)nxt.pm * tstep : cA);
        const char* nB = has_next ? (const char*)(g.Bt + (size_t)nxt.bsel * g.bstride) + (size_t)nxt.pn * tstep : cB;
        for (int t = 0; t < nt; t += 2) {
            const bool last = (t == nt - 2);
            const char* a1 = cA + (size_t)(t + 1) * kstep;
            const char* a2 = last ? nA : cA + (size_t)(t + 2) * kstep; const char* b2 = last ? nB : cB + (size_t)(t + 2) * kstep;
            const char* a3 = a2 + kstep; const char* b3 = b2 + kstep;
            PG8_LDB(B0, 0, 0); PG8_LDB(B1, 0, 1); PG8_SCHED; PG8_LDA(At, 0, 0); PG8_STAGE2(PG8_SA(1, 1), a1 + ah, vA[1][0], vA[1][1]);
            if constexpr (GA) { if (last) {
#pragma unroll
                for (int h = 0; h < 2; ++h)
#pragma unroll
                    for (int i = 0; i < 2; ++i) vA[h][i] = (unsigned)(S.tokl[h * HALF + RA[i]] * K + CA[i]) * 2u; } }
            PG8_WAIT_V(8); PG8_WAIT_L(0); PG8_BAR; PG8_MMA(0, 0, At, B0); PG8_MMA(0, 1, At, B1); PG8_BAR; PG8_SCHED;
            PG8_LDA(At, 0, 1); PG8_STAGEB(PG8_SB(0, 0), b2); PG8_STAGEB(PG8_SB(0, 1), b2 + hstep); PG8_STAGE2(PG8_SA(0, 0), a2, vA[0][0], vA[0][1]);
            PG8_WAIT_V(8); PG8_WAIT_L(0); PG8_BAR; PG8_MMA(1, 0, At, B0); PG8_MMA(1, 1, At, B1); PG8_BAR; PG8_SCHED;
            PG8_LDB(B0, 1, 0); PG8_LDB(B1, 1, 1); PG8_SCHED; PG8_LDA(At, 1, 0); PG8_STAGE2(PG8_SA(0, 1), a2 + ah, vA[1][0], vA[1][1]);
            PG8_WAIT_V(8); PG8_WAIT_L(0); PG8_BAR; PG8_MMA(0, 0, At, B0); PG8_MMA(0, 1, At, B1); PG8_BAR; PG8_SCHED;
            PG8_LDA(At, 1, 1); PG8_STAGEB(PG8_SB(1, 0), b3); PG8_STAGEB(PG8_SB(1, 1), b3 + hstep); PG8_STAGE2(PG8_SA(1, 0), a3, vA[0][0], vA[0][1]);
            PG8_WAIT_V(8); PG8_WAIT_L(0); PG8_BAR; PG8_MMA(1, 0, At, B0); PG8_MMA(1, 1, At, B1); PG8_BAR; PG8_SCHED;
        }
        if (wr == 0) PG8_BAR;
        E(acc, cur, wr, wc, fr, fq);
        if (!has_next) break;
#pragma unroll
        for (int a = 0; a < 2; ++a)
#pragma unroll
            for (int b = 0; b < 2; ++b)
#pragma unroll
                for (int m = 0; m < 4; ++m)
#pragma unroll
                    for (int n = 0; n < 2; ++n) acc[a][b][m][n] = (f32x4){0.f, 0.f, 0.f, 0.f};
        cur = nxt; cA = nA; cB = nB; ++ui;
        if (wr == 1) PG8_BAR;
    }
    PG8_WAIT_V(0);
    PG8_BAR;
#undef PG8_SA
#undef PG8_SB
#undef PG8_STAGE2
#undef PG8_STAGEB
#undef PG8_LDA
#undef PG8_LDB
#undef PG8_MMA
#undef PG8_WAIT_V
#undef PG8_WAIT_L
#undef PG8_BAR
#undef PG8_SCHED
}
}

namespace att {
typedef short bf16x8 __attribute__((ext_vector_type(8)));
typedef short s16x4 __attribute__((ext_vector_type(4)));
typedef float f32x16 __attribute__((ext_vector_type(16)));
constexpr int KVBLK = 64, SHM_K = 16384, SHM_V = 16384;
constexpr float LOG2E = 1.4426950408889634f;
#define KSWZ(row, colB) ((row) * 256 + ((colB) ^ (((row) & 7) << 4)))
#define SBAR() __builtin_amdgcn_sched_barrier(0)
DEV int v_st(int k, int c) { const int kk = (k & ~0xC) | ((k & 4) << 1) | ((k & 8) >> 1); return ((kk >> 3) * 4 + (c >> 5)) * 512 + ((kk & 7) * 32 + (c & 31)) * 2; }
DEV int v_rd_base(int lane) { return ((lane & 3) << 3) | (((lane >> 2) & 3) << 6) | (((lane >> 4) & 1) << 5) | (((lane >> 5) & 1) << 8); }
constexpr int v_rd_off(int d0, int ks, int half) { return d0 * 512 + ks * 4096 + half * 2048; }
DEV int crow(int r, int hi) { return (r & 3) + 8 * (r >> 2) + 4 * hi; }
DEV unsigned cvtpk(float lo, float hi) { unsigned r; asm volatile("v_cvt_pk_bf16_f32 %0, %1, %2" : "=v"(r) : "v"(lo), "v"(hi)); return r; }
template <int ND>
DEV void qkt(f32x16& p0, f32x16& p1, const char* kbase, int r32, int hi, const bf16x8* qr) {
    p0 = f32x16{}; p1 = f32x16{};
    const char* kb[4];
#pragma unroll
    for (int dd = 0; dd < 4; ++dd) kb[dd] = kbase + KSWZ(r32, (dd * 16 + hi * 8) * 2);
#pragma unroll
    for (int d0 = 0; d0 < ND; ++d0) { const char* a = kb[d0 & 3] + (d0 >> 2) * 128;
        bf16x8 b0 = *reinterpret_cast<const bf16x8*>(a);
        bf16x8 b1 = *reinterpret_cast<const bf16x8*>(a + 32 * 256);
        p0 = __builtin_amdgcn_mfma_f32_32x32x16_bf16(b0, qr[d0], p0, 0, 0, 0);
        p1 = __builtin_amdgcn_mfma_f32_32x32x16_bf16(b1, qr[d0], p1, 0, 0, 0); }
}
DEV void qkt_half_acc(f32x16& p0, const char* kbase, int r32, int hi, const bf16x8* qr) {
    const char* kb[4];
#pragma unroll
    for (int dd = 0; dd < 4; ++dd) kb[dd] = kbase + KSWZ(r32, (dd * 16 + hi * 8) * 2);
#pragma unroll
    for (int d0 = 0; d0 < 8; ++d0) { const char* a = kb[d0 & 3] + (d0 >> 2) * 128;
        bf16x8 b0 = *reinterpret_cast<const bf16x8*>(a);
        p0 = __builtin_amdgcn_mfma_f32_32x32x16_bf16(b0, qr[d0], p0, 0, 0, 0); }
}
template <int VB, int ND0 = 4>
DEV void pv_tile(f32x16* o, int vb0, bf16x8 pa0, bf16x8 pa1, bf16x8 pa2, bf16x8 pa3) {
#define TRRD(dst, off) asm volatile("ds_read_b64_tr_b16 %0, %1 offset:%2" : "=&v"(dst) : "v"(vb0), "i"(off) : "memory")
#define PV_D0(d0) do { s16x4 l0, l1, l2, l3, h0, h1, h2, h3; constexpr int b_ = VB * SHM_V + v_rd_off(d0, 0, 0);   \
        TRRD(l0, b_); TRRD(h0, b_ + 2048); TRRD(l1, b_ + 4096); TRRD(h1, b_ + 6144); TRRD(l2, b_ + 8192); TRRD(h2, b_ + 10240); TRRD(l3, b_ + 12288); TRRD(h3, b_ + 14336); \
        asm volatile("s_waitcnt lgkmcnt(0)" ::: "memory"); SBAR();   \
        o[d0] = __builtin_amdgcn_mfma_f32_32x32x16_bf16(pa0, (bf16x8){l0[0], l0[1], l0[2], l0[3], h0[0], h0[1], h0[2], h0[3]}, o[d0], 0, 0, 0);   \
        o[d0] = __builtin_amdgcn_mfma_f32_32x32x16_bf16(pa1, (bf16x8){l1[0], l1[1], l1[2], l1[3], h1[0], h1[1], h1[2], h1[3]}, o[d0], 0, 0, 0);   \
        o[d0] = __builtin_amdgcn_mfma_f32_32x32x16_bf16(pa2, (bf16x8){l2[0], l2[1], l2[2], l2[3], h2[0], h2[1], h2[2], h2[3]}, o[d0], 0, 0, 0);   \
        o[d0] = __builtin_amdgcn_mfma_f32_32x32x16_bf16(pa3, (bf16x8){l3[0], l3[1], l3[2], l3[3], h3[0], h3[1], h3[2], h3[3]}, o[d0], 0, 0, 0); } while (0)
    PV_D0(0); if constexpr (ND0 > 1) PV_D0(1); if constexpr (ND0 > 2) { PV_D0(2); PV_D0(3); }
#undef PV_D0
#undef TRRD
}
DEV void pack_p(const f32x16& p0, const f32x16& p1, bf16x8& pa0, bf16x8& pa1, bf16x8& pa2, bf16x8& pa3) {
#define PK4(P, B_, OUT) do { unsigned a0 = cvtpk(P[B_+0], P[B_+1]), a1 = cvtpk(P[B_+2], P[B_+3]);                          \
        unsigned b0 = cvtpk(P[B_+4], P[B_+5]), b1 = cvtpk(P[B_+6], P[B_+7]);                                             \
        auto r0 = __builtin_amdgcn_permlane32_swap(a0, b0, false, false); auto r1 = __builtin_amdgcn_permlane32_swap(a1, b1, false, false); \
        u32x4 w = {r0[0], r1[0], r0[1], r1[1]}; OUT = *reinterpret_cast<bf16x8*>(&w); } while (0)
    PK4(p0, 0, pa0); PK4(p0, 8, pa1); PK4(p1, 0, pa2); PK4(p1, 8, pa3);
#undef PK4
}
DEV float half_max(float v) { auto rr = __builtin_amdgcn_permlane32_swap(__float_as_uint(v), __float_as_uint(v), false, false); return fmaxf(__uint_as_float(rr[0]), __uint_as_float(rr[1])); }
DEV float half_sum(float v) { auto rr = __builtin_amdgcn_permlane32_swap(__float_as_uint(v), __float_as_uint(v), false, false); return __uint_as_float(rr[0]) + __uint_as_float(rr[1]); }

constexpr int L_V = 0, L_K = 2 * SHM_V, L_WS = L_K + 2 * SHM_K, L_BT = L_WS + 8 * 256, L_QW = L_BT + 512, L_END = L_QW + 512;

DEV void moba_unit(const Params& P, char* lds, int layer, int b, int h, int qb) {
    const int tid = opaque_tid(), wid = __builtin_amdgcn_readfirstlane(tid >> 6), lane = tid & 63, r32 = lane & 31, hi = lane >> 5;
    const bf16* QKV = (const bf16*)(P.ws + WS_BIG);
    char* V_lds = lds + L_V; char* K_lds = lds + L_K;
    float* wsf = (float*)(lds + L_WS) + wid * 64; float* li_l = wsf; float* al_l = wsf + 32;
    float* bt = (float*)(lds + L_BT); const float* qw = (const float*)(lds + L_QW);
    const int sr = tid >> 4, sc = (tid & 15) * 8, vst0 = v_st(sr, sc), vst1 = v_st(32 + sr, sc), kws = KSWZ(sr, sc * 2);
    const int vb0 = (int)(uintptr_t)V_lds + v_rd_base(lane);
    const size_t tok0 = (size_t)b * SEQ;
    if (tid < 128) bt[tid] = ((const float*)(P.ws + WS_BT))[h * 128 + tid];
    if (tid < 256) { const int row = tid >> 4, ch = tid & 15; const float* km = (const float*)(P.ws + WS_KMEAN) + ((((size_t)b * 16 + row) * 8 + h) * 128 + ch * 8);
        const f32x4 a = *(const f32x4*)km, c = *(const f32x4*)(km + 4);
        float x[8] = {a.x, a.y, a.z, a.w, c.x, c.y, c.z, c.w}; unsigned hw[4], lw[4];
#pragma unroll
        for (int i = 0; i < 4; ++i) { const unsigned h0 = f2bf(x[2 * i]), h1 = f2bf(x[2 * i + 1]); hw[i] = h0 | (h1 << 16);
            lw[i] = pk2(x[2 * i] - __uint_as_float(h0 << 16), x[2 * i + 1] - __uint_as_float(h1 << 16)); }
        *(u32x4*)(K_lds + KSWZ(row, ch * 16)) = (u32x4){hw[0], hw[1], hw[2], hw[3]};
        *(u32x4*)(K_lds + SHM_K + KSWZ(row, ch * 16)) = (u32x4){lw[0], lw[1], lw[2], lw[3]}; }
    bf16x8 qr[8];
    { const bf16* qp = QKV + (tok0 + qb * 256 + wid * 32 + r32) * ODN + h * 128 + hi * 8;
      u32x4 raw[8]; float ss = 0.f;
#pragma unroll
      for (int d0 = 0; d0 < 8; ++d0) { raw[d0] = *(const u32x4*)(qp + d0 * 16);
#pragma unroll
          for (int i = 0; i < 4; ++i) { const float lo = bflo(raw[d0][i]), hh = bfhi(raw[d0][i]); ss += lo * lo + hh * hh; } }
      ss = half_sum(ss);
      const float rs = rsqrtf(ss * (1.f / 128.f) + RMS_EPS);
      __syncthreads();
#pragma unroll
      for (int d0 = 0; d0 < 8; ++d0) { const f32x4 w0 = *(const f32x4*)(qw + d0 * 16 + hi * 8), w1 = *(const f32x4*)(qw + d0 * 16 + hi * 8 + 4);
          u32x4 o; o.x = cvtpk(bflo(raw[d0].x) * rs * w0.x, bfhi(raw[d0].x) * rs * w0.y); o.y = cvtpk(bflo(raw[d0].y) * rs * w0.z, bfhi(raw[d0].y) * rs * w0.w);
          o.z = cvtpk(bflo(raw[d0].z) * rs * w1.x, bfhi(raw[d0].z) * rs * w1.y); o.w = cvtpk(bflo(raw[d0].w) * rs * w1.z, bfhi(raw[d0].w) * rs * w1.w);
          qr[d0] = *reinterpret_cast<bf16x8*>(&o); } }
    unsigned selmask = 0u;
    { f32x16 ps = f32x16{};
      qkt_half_acc(ps, K_lds, r32, hi, qr); qkt_half_acc(ps, K_lds + SHM_K, r32, hi, qr);
      float scv[16];
#pragma unroll
      for (int r = 0; r < 8; ++r) { const float mine = ps[r], oth = __shfl_xor(mine, 32); const int jm = (r & 3) + 8 * (r >> 2);
          scv[jm + 4 * 0] = hi ? oth : mine; scv[jm + 4] = hi ? mine : oth; }
#pragma unroll
      for (int j = 0; j < 16; ++j) if (j >= qb) scv[j] = -INFINITY;
#pragma unroll
      for (int n = 0; n < 3; ++n) { float mx = -INFINITY; int ix = -1;
#pragma unroll
          for (int j = 0; j < 16; ++j) if (scv[j] > mx) { mx = scv[j]; ix = j; }
#pragma unroll
          for (int j = 0; j < 16; ++j) if (j == ix) scv[j] = -INFINITY;
          if (ix >= 0) selmask |= 1u << ix; } }
    __syncthreads();
    const int NT = 4 * (qb + 1);
    const int qrow = wid * 32 + r32;
    const bf16* Kg = QKV + tok0 * ODN + 1024 + h * 128 + sc; const bf16* Vg = Kg + 1024;
    bf16x8 st_k0, st_k1, st_v0, st_v1;
#define SLOAD(t) do { const size_t k0_ = (size_t)(t) * 64; st_k0 = *(const bf16x8*)(Kg + (k0_ + sr) * ODN); st_k1 = *(const bf16x8*)(Kg + (k0_ + 32 + sr) * ODN); \
                      st_v0 = *(const bf16x8*)(Vg + (k0_ + sr) * ODN); st_v1 = *(const bf16x8*)(Vg + (k0_ + 32 + sr) * ODN); } while (0)
#define SWRITE(bf) do { *(bf16x8*)(K_lds + (bf) * SHM_K + kws) = st_k0; *(bf16x8*)(K_lds + (bf) * SHM_K + kws + 32 * 256) = st_k1; \
                        *(bf16x8*)(V_lds + (bf) * SHM_V + vst0) = st_v0; *(bf16x8*)(V_lds + (bf) * SHM_V + vst1) = st_v1; } while (0)
    float m_reg = -1e30f, l_reg = 0.f; f32x16 o[4] = {};
    const float cfar = bt[127];
    SLOAD(0); SWRITE(0); __syncthreads();
#define TILE_STEP(t, BUF) do { \
        if ((t) + 1 < NT) SLOAD((t) + 1); \
        const int jb_ = (t) >> 2, tt_ = (t) & 3; const bool own_ = (jb_ == qb); \
        const bool need_ = own_ ? (tt_ * 64 <= wid * 32 + 31) : (__ballot((selmask >> jb_) & 1u) != 0ull);     \
        if (need_) { \
            f32x16 p0, p1; qkt<8>(p0, p1, K_lds + (BUF) * SHM_K, r32, hi, qr); \
            const int dq_ = (qb - jb_) * 256 + qrow - tt_ * 64 - 4 * hi;                   \
            const bool far_ = ((qb - jb_) * 256 + wid * 32 - tt_ * 64 - 63) >= 127;        \
            if (far_) { _Pragma("unroll") for (int r = 0; r < 16; ++r) { p0[r] = fmaf(p0[r], 0.08838834764831845f, cfar); p1[r] = fmaf(p1[r], 0.08838834764831845f, cfar); } } \
            else { _Pragma("unroll") for (int r = 0; r < 16; ++r) { const int c_ = (r & 3) + 8 * (r >> 2); const int d0_ = dq_ - c_, d1_ = d0_ - 32; \
                       const float b0_ = bt[d0_ < 0 ? 0 : (d0_ > 127 ? 127 : d0_)], b1_ = bt[d1_ < 0 ? 0 : (d1_ > 127 ? 127 : d1_)]; \
                       p0[r] = d0_ < 0 ? -INFINITY : fmaf(p0[r], 0.08838834764831845f, b0_); p1[r] = d1_ < 0 ? -INFINITY : fmaf(p1[r], 0.08838834764831845f, b1_); } } \
            if (!own_ && !((selmask >> jb_) & 1u)) { _Pragma("unroll") for (int r = 0; r < 16; ++r) { p0[r] = -INFINITY; p1[r] = -INFINITY; } } \
            float pmax_ = p0[0]; _Pragma("unroll") for (int r = 1; r < 16; ++r) pmax_ = fmaxf(pmax_, p0[r]); _Pragma("unroll") for (int r = 0; r < 16; ++r) pmax_ = fmaxf(pmax_, p1[r]); \
            pmax_ = half_max(pmax_); \
            const float mn_ = fmaxf(m_reg, pmax_); const float alpha_ = __builtin_amdgcn_exp2f((m_reg - mn_) * LOG2E); m_reg = mn_; \
            const float mnl_ = -mn_ * LOG2E; float psum_ = 0.f; \
            _Pragma("unroll") for (int r = 0; r < 16; ++r) { p0[r] = __builtin_amdgcn_exp2f(fmaf(p0[r], LOG2E, mnl_)); p1[r] = __builtin_amdgcn_exp2f(fmaf(p1[r], LOG2E, mnl_)); psum_ += p0[r] + p1[r]; } \
            psum_ = half_sum(psum_); l_reg = l_reg * alpha_ + psum_; \
            bf16x8 pa0, pa1, pa2, pa3; pack_p(p0, p1, pa0, pa1, pa2, pa3); \
            if (__any(alpha_ < 1.f)) { if (hi == 0) al_l[r32] = alpha_; asm volatile("s_waitcnt lgkmcnt(0)" ::: "memory"); \
                _Pragma("unroll") for (int d_ = 0; d_ < 4; ++d_) _Pragma("unroll") for (int r = 0; r < 16; ++r) o[d_][r] *= al_l[crow(r, hi)]; } \
            pv_tile<BUF>(o, vb0, pa0, pa1, pa2, pa3); \
        } \
        if ((t) + 1 < NT) { SWRITE((BUF) ^ 1); } \
        __syncthreads(); } while (0)
    for (int t = 0; t < NT; t += 2) { TILE_STEP(t, 0); TILE_STEP(t + 1, 1); }
#undef TILE_STEP
#undef SLOAD
#undef SWRITE
    if (hi == 0) li_l[r32] = l_reg; asm volatile("s_waitcnt lgkmcnt(0)" ::: "memory");
    bf16* Ow = (bf16*)(P.ws + WS_MIX) + (tok0 + qb * 256 + wid * 32) * DM + h * 128;
#pragma unroll
    for (int r = 0; r < 16; ++r) { const int orow = crow(r, hi); const float rl = __builtin_amdgcn_rcpf(li_l[orow]);
#pragma unroll
        for (int d0 = 0; d0 < 4; ++d0) { const float v = o[d0][r] * rl; const float vn = __shfl_xor(v, 1);
            if ((r32 & 1) == 0) *(unsigned*)(Ow + (size_t)orow * DM + d0 * 32 + r32) = cvtpk(v, vn); } }
    __syncthreads();
}
DEV void phase_moba(const Params& P, unsigned char* lds, int vb, int nvb, int layer) {
    { const int tid = opaque_tid(); if (tid < 128) ((float*)(lds + L_QW))[tid] = P.in[I_CQN][(layer >> 1) * 128 + tid]; }
    __syncthreads();
    for (int it = vb; it < NBATCH * 8 * 8; it += nvb) {
        const int pr = it & 7, h = (it >> 3) & 7, b = it >> 6;
        moba_unit(P, (char*)lds, layer, b, h, pr);
        moba_unit(P, (char*)lds, layer, b, h, 15 - pr);
    }
}

constexpr int S_V = 0, S_K = 65536, S_WS = 131072, S_BT = S_WS + 2048, S_QW = S_BT + 2048, S_KW = S_QW + 256;
DEV void swa_unit(const Params& P, char* lds, int layer, int b, int kvh, int n) {
    const int tid = opaque_tid(), wid = __builtin_amdgcn_readfirstlane(tid >> 6), lane = tid & 63, r32 = lane & 31, hi = lane >> 5;
    const int g = wid >> 1, h = kvh * 4 + g, jl = layer >> 1;
    const bf16* QKV = (const bf16*)(P.ws + WS_BIG);
    char* V_lds = lds + S_V; char* K_lds = lds + S_K;
    float* wsf = (float*)(lds + S_WS) + wid * 64; float* li_l = wsf; float* al_l = wsf + 32;
    const float* bt = (const float*)(lds + S_BT) + g * 128; const float* qw = (const float*)(lds + S_QW); const float* kw = (const float*)(lds + S_KW);
    ((float*)(lds + S_BT))[tid] = ((const float*)(P.ws + WS_BT))[(kvh * 4 + (tid >> 7)) * 128 + (tid & 127)];
#pragma unroll
    for (int i = 0; i < 4; ++i) { const int idx = tid + 512 * i, key = idx >> 3, ch = idx & 7, s = (n - 1) * 128 + key;
        u32x4 kr = (u32x4){0u, 0u, 0u, 0u}, vr = kr;
        if (s >= 0) { const bf16* rp = QKV + ((size_t)b * SEQ + s) * EVN; kr = *(const u32x4*)(rp + 512 + kvh * 64 + ch * 8); vr = *(const u32x4*)(rp + 640 + kvh * 64 + ch * 8); }
        float kf[8] = {bflo(kr.x), bfhi(kr.x), bflo(kr.y), bfhi(kr.y), bflo(kr.z), bfhi(kr.z), bflo(kr.w), bfhi(kr.w)};
        float ss = 0.f;
#pragma unroll
        for (int e = 0; e < 8; ++e) ss += kf[e] * kf[e];
        ss += __shfl_xor(ss, 1); ss += __shfl_xor(ss, 2); ss += __shfl_xor(ss, 4);
        const float rs = rsqrtf(ss * (1.f / 64.f) + RMS_EPS);
        const f32x4 w0 = *(const f32x4*)(kw + ch * 8), w1 = *(const f32x4*)(kw + ch * 8 + 4);
        u32x4 ko; ko.x = cvtpk(kf[0] * rs * w0.x, kf[1] * rs * w0.y); ko.y = cvtpk(kf[2] * rs * w0.z, kf[3] * rs * w0.w); ko.z = cvtpk(kf[4] * rs * w1.x, kf[5] * rs * w1.y); ko.w = cvtpk(kf[6] * rs * w1.z, kf[7] * rs * w1.w);
        *(u32x4*)(K_lds + (key >> 6) * SHM_K + KSWZ(key & 63, ch * 16)) = ko;
        *(u32x4*)(V_lds + (key >> 6) * SHM_V + v_st(key & 63, ch * 8)) = vr; }
    __syncthreads();
    const int vb0 = (int)(uintptr_t)V_lds + v_rd_base(lane);
    const float sink = P.in[I_ASINK][jl * 8 + h];
#pragma unroll 1
    for (int gi = 0; gi < 2; ++gi) {
        const int q0 = (wid & 1) * 64 + gi * 32; const size_t tok = (size_t)b * SEQ + n * 128 + q0 + r32;
        bf16x8 qr[4];
        { const bf16* qp = QKV + tok * EVN + h * 64 + hi * 8; u32x4 raw[4]; float ss = 0.f;
#pragma unroll
          for (int d0 = 0; d0 < 4; ++d0) { raw[d0] = *(const u32x4*)(qp + d0 * 16);
#pragma unroll
              for (int i = 0; i < 4; ++i) { const float lo = bflo(raw[d0][i]), hh = bfhi(raw[d0][i]); ss += lo * lo + hh * hh; } }
          ss = half_sum(ss); const float rs = rsqrtf(ss * (1.f / 64.f) + RMS_EPS);
#pragma unroll
          for (int d0 = 0; d0 < 4; ++d0) { const f32x4 w0 = *(const f32x4*)(qw + d0 * 16 + hi * 8), w1 = *(const f32x4*)(qw + d0 * 16 + hi * 8 + 4);
              u32x4 o; o.x = cvtpk(bflo(raw[d0].x) * rs * w0.x, bfhi(raw[d0].x) * rs * w0.y); o.y = cvtpk(bflo(raw[d0].y) * rs * w0.z, bfhi(raw[d0].y) * rs * w0.w);
              o.z = cvtpk(bflo(raw[d0].z) * rs * w1.x, bfhi(raw[d0].z) * rs * w1.y); o.w = cvtpk(bflo(raw[d0].w) * rs * w1.z, bfhi(raw[d0].w) * rs * w1.w);
              qr[d0] = *reinterpret_cast<bf16x8*>(&o); } }
        float m_reg = sink, l_reg = 1.f; f32x16 o2[2] = {};
        const int tile0 = q0 >> 6;
#pragma unroll 1
        for (int tt = 0; tt < 3; ++tt) {
            const int tile = tile0 + tt;
            if (n == 0 && tile < 2) continue;
            f32x16 p0, p1; qkt<4>(p0, p1, K_lds + tile * SHM_K, r32, hi, qr);
            const int dq = 128 + q0 + r32 - tile * 64 - 4 * hi;
#pragma unroll
            for (int r = 0; r < 16; ++r) { const int c = (r & 3) + 8 * (r >> 2); const int d0_ = dq - c, d1_ = d0_ - 32;
                const float b0_ = bt[d0_ & 127], b1_ = bt[d1_ & 127];
                p0[r] = ((unsigned)d0_ < 128u) ? fmaf(p0[r], 0.125f, b0_) : -INFINITY; p1[r] = ((unsigned)d1_ < 128u) ? fmaf(p1[r], 0.125f, b1_) : -INFINITY; }
            float pmax = p0[0];
#pragma unroll
            for (int r = 1; r < 16; ++r) pmax = fmaxf(pmax, p0[r]);
#pragma unroll
            for (int r = 0; r < 16; ++r) pmax = fmaxf(pmax, p1[r]);
            pmax = half_max(pmax);
            const float mn = fmaxf(m_reg, pmax), alpha = __builtin_amdgcn_exp2f((m_reg - mn) * LOG2E); m_reg = mn;
            const float mnl = -mn * LOG2E; float psum = 0.f;
#pragma unroll
            for (int r = 0; r < 16; ++r) { p0[r] = __builtin_amdgcn_exp2f(fmaf(p0[r], LOG2E, mnl)); p1[r] = __builtin_amdgcn_exp2f(fmaf(p1[r], LOG2E, mnl)); psum += p0[r] + p1[r]; }
            psum = half_sum(psum); l_reg = l_reg * alpha + psum;
            bf16x8 pa0, pa1, pa2, pa3; pack_p(p0, p1, pa0, pa1, pa2, pa3);
            if (__any(alpha < 1.f)) { if (hi == 0) al_l[r32] = alpha; asm volatile("s_waitcnt lgkmcnt(0)" ::: "memory");
#pragma unroll
                for (int d_ = 0; d_ < 2; ++d_)
#pragma unroll
                    for (int r = 0; r < 16; ++r) o2[d_][r] *= al_l[crow(r, hi)]; }
            pv_tile<0, 2>(o2, vb0 + tile * SHM_V, pa0, pa1, pa2, pa3);
        }
        if (hi == 0) li_l[r32] = l_reg; asm volatile("s_waitcnt lgkmcnt(0)" ::: "memory");
        bf16* Ow = (bf16*)(P.ws + WS_MIX) + ((size_t)b * SEQ + n * 128 + q0) * DM + h * 64;
#pragma unroll
        for (int r = 0; r < 16; ++r) { const int orow = crow(r, hi); const float rl = __builtin_amdgcn_rcpf(li_l[orow]);
#pragma unroll
            for (int d0 = 0; d0 < 2; ++d0) { const float v = o2[d0][r] * rl; const float vn = __shfl_xor(v, 1);
                if ((r32 & 1) == 0) *(unsigned*)(Ow + (size_t)orow * DM + d0 * 32 + r32) = cvtpk(v, vn); } }
        asm volatile("s_waitcnt lgkmcnt(0)" ::: "memory");
    }
    __syncthreads();
}
DEV void phase_swa(const Params& P, unsigned char* lds, int vb, int nvb, int layer) {
    { const int tid = opaque_tid(); if (tid < 64) { ((float*)(lds + S_QW))[tid] = P.in[I_AQN][(layer >> 1) * 64 + tid]; ((float*)(lds + S_KW))[tid] = P.in[I_AKN][(layer >> 1) * 64 + tid]; } }
    __syncthreads();
    for (int it = vb; it < NBATCH * 2 * 32; it += nvb) swa_unit(P, (char*)lds, layer, it >> 6, (it >> 5) & 1, it & 31);
}

constexpr int G_G = 0, G_K = 16384, G_V = 32768, G_S = 49152, G_QD = 65536, G_KT = 73728, G_SEG = 81920, G_WS = 83968;
DEV void gla_gates(const Params& P, char* lds, int layer, int b, int h, int n, int tid) {
    const int seg = tid >> 6, dk = tid & 63, jl = layer >> 1;
    float* G = (float*)(lds + G_G); float* segs = (float*)(lds + G_SEG);
    float gu[16];
#pragma unroll
    for (int r = 0; r < 16; ++r) gu[r] = P.in[I_BGU][((size_t)jl * 16 + r) * 256 + h * 64 + dk];
    const float bias = P.in[I_BGB][jl * 256 + h * 64 + dk];
    const float* AB = (const float*)(P.ws + WS_AB) + ((size_t)b * SEQ + n * 64 + seg * 8) * 16;
    float vals[8], run = 0.f;
#pragma unroll
    for (int i = 0; i < 8; ++i) { const f32x4 a0 = *(const f32x4*)(AB + i * 16), a1 = *(const f32x4*)(AB + i * 16 + 4), a2 = *(const f32x4*)(AB + i * 16 + 8), a3 = *(const f32x4*)(AB + i * 16 + 12);
        float z = bias;
        z += a0.x * gu[0] + a0.y * gu[1] + a0.z * gu[2] + a0.w * gu[3]; z += a1.x * gu[4] + a1.y * gu[5] + a1.z * gu[6] + a1.w * gu[7];
        z += a2.x * gu[8] + a2.y * gu[9] + a2.z * gu[10] + a2.w * gu[11]; z += a3.x * gu[12] + a3.y * gu[13] + a3.z * gu[14] + a3.w * gu[15];
        run += log_sigmoid_f(z) * (1.f / 16.f); vals[i] = run; }
    segs[seg * 64 + dk] = run;
    __syncthreads();
    float pre = 0.f;
#pragma unroll
    for (int s = 0; s < 8; ++s) pre += (s < seg) ? segs[s * 64 + dk] : 0.f;
#pragma unroll
    for (int i = 0; i < 8; ++i) G[(seg * 8 + i) * 64 + dk] = vals[i] + pre;
    __syncthreads();
}
DEV void gla_stage_v(const bf16* src, size_t pitch, char* dst, int tid) {
#pragma unroll
    for (int i = 0; i < 2; ++i) { const int idx = tid + 512 * i, row = idx >> 4, ch = idx & 15; *(u32x4*)(dst + v_st(row, ch * 8)) = *(const u32x4*)(src + (size_t)row * pitch + ch * 8); }
}
DEV void gla_local_unit(const Params& P, char* lds, int layer, int b, int h, int n) {
    const int tid = opaque_tid(), wid = __builtin_amdgcn_readfirstlane(tid >> 6), lane = tid & 63, r32 = lane & 31, hi = lane >> 5;
    const bf16* QKV = (const bf16*)(P.ws + WS_BIG); const float* G = (const float*)(lds + G_G);
    const int chd = (b * 4 + h) * 64 + n; const size_t tok0 = (size_t)b * SEQ + n * 64;
    gla_gates(P, lds, layer, b, h, n, tid);
    { const int j = tid >> 3, c8 = (tid & 7) * 8; const u32x4 kr = *(const u32x4*)(QKV + (tok0 + j) * EVN + 1024 + h * 64 + c8);
      const float kf[8] = {bflo(kr.x), bfhi(kr.x), bflo(kr.y), bfhi(kr.y), bflo(kr.z), bfhi(kr.z), bflo(kr.w), bfhi(kr.w)};
      bf16* kdT = (bf16*)(lds + G_KT);
#pragma unroll
      for (int e = 0; e < 8; ++e) { const float bl = G[63 * 64 + c8 + e], bj = G[j * 64 + c8 + e]; kdT[(c8 + e) * 64 + j] = (bf16)f2bf(kf[e] * __expf(bl - bj));
          if (j == 63) ((float*)(P.ws + WS_DEC))[(size_t)chd * 64 + c8 + e] = __expf(bl); } }
    gla_stage_v(QKV + tok0 * EVN + 1280 + h * 128, EVN, lds + G_V, tid);
    __syncthreads();
    const int rh = wid >> 2, dq = wid & 3;
    bf16x8 pa[4];
#pragma unroll
    for (int ks = 0; ks < 4; ++ks) pa[ks] = *(const bf16x8*)(lds + G_KT + ((32 * rh + r32) * 64 + ks * 16 + hi * 8) * 2);
    f32x16 o1[1] = {};
    pv_tile<0, 1>(o1, (int)(uintptr_t)(lds + G_V) + v_rd_base(lane) + dq * 512, pa[0], pa[1], pa[2], pa[3]);
    float* UPD = (float*)(P.ws + WS_UPD) + (size_t)chd * 64 * 128;
#pragma unroll
    for (int r = 0; r < 16; ++r) UPD[(32 * rh + crow(r, hi)) * 128 + dq * 32 + r32] = o1[0][r];
    __syncthreads();
}
DEV void phase_gla_scan(const Params& P, int vb, int nvb) {
    const int tid = opaque_tid();
    const float* UPD = (const float*)(P.ws + WS_UPD); const float* DEC = (const float*)(P.ws + WS_DEC); bf16* SIN = (bf16*)(P.ws + WS_SIN);
    for (int e = vb * 512 + tid; e < 32 * 64 * 64; e += nvb * 512) {
        const int dvp = e & 63, dk = (e >> 6) & 63, bh = e >> 12;
        float s0 = 0.f, s1 = 0.f;
#pragma unroll 8
        for (int n = 0; n < 64; ++n) { const size_t ro = ((size_t)(bh * 64 + n) * 64 + dk);
            const f32x2 u = *(const f32x2*)(UPD + ro * 128 + 2 * dvp); const float d = DEC[ro];
            *(unsigned*)(SIN + ro * 128 + 2 * dvp) = pk2(s0, s1);
            s0 = s0 * d + u.x; s1 = s1 * d + u.y; }
    }
}
DEV void gla_final_unit(const Params& P, char* lds, int layer, int b, int h, int n) {
    const int tid = opaque_tid(), wid = __builtin_amdgcn_readfirstlane(tid >> 6), lane = tid & 63, r32 = lane & 31, hi = lane >> 5;
    const bf16* QKV = (const bf16*)(P.ws + WS_BIG); const float* G = (const float*)(lds + G_G);
    const int chd = (b * 4 + h) * 64 + n, jl = layer >> 1; const size_t tok0 = (size_t)b * SEQ + n * 64;
    gla_gates(P, lds, layer, b, h, n, tid);
    { const int j = tid >> 3, c8 = (tid & 7) * 8; const bf16* rp = QKV + (tok0 + j) * EVN + h * 64 + c8;
      const u32x4 qv = *(const u32x4*)(rp + 768), kr = *(const u32x4*)(rp + 1024);
      const float qf_[8] = {bflo(qv.x), bfhi(qv.x), bflo(qv.y), bfhi(qv.y), bflo(qv.z), bfhi(qv.z), bflo(qv.w), bfhi(qv.w)};
      const float kf[8] = {bflo(kr.x), bfhi(kr.x), bflo(kr.y), bfhi(kr.y), bflo(kr.z), bfhi(kr.z), bflo(kr.w), bfhi(kr.w)};
      float qd_[8], ki_[8];
#pragma unroll
      for (int e = 0; e < 8; ++e) { const float bj = G[j * 64 + c8 + e]; qd_[e] = qf_[e] * 0.125f * __expf(bj); ki_[e] = kf[e] * __expf(-bj); }
      *(u32x4*)(lds + G_QD + (j * 64 + c8) * 2) = (u32x4){cvtpk(qd_[0], qd_[1]), cvtpk(qd_[2], qd_[3]), cvtpk(qd_[4], qd_[5]), cvtpk(qd_[6], qd_[7])};
      *(u32x4*)(lds + G_K + KSWZ(j, c8 * 2)) = (u32x4){cvtpk(ki_[0], ki_[1]), cvtpk(ki_[2], ki_[3]), cvtpk(ki_[4], ki_[5]), cvtpk(ki_[6], ki_[7])}; }
    gla_stage_v(QKV + tok0 * EVN + 1280 + h * 128, EVN, lds + G_V, tid);
    gla_stage_v((const bf16*)(P.ws + WS_SIN) + (size_t)chd * 64 * 128, 128, lds + G_S, tid);
    __syncthreads();
    const int rh = wid >> 2, dq = wid & 3, irow = 32 * rh + r32;
    bf16x8 qf[4];
#pragma unroll
    for (int d0 = 0; d0 < 4; ++d0) qf[d0] = *(const bf16x8*)(lds + G_QD + (irow * 64 + d0 * 16 + hi * 8) * 2);
    f32x16 p0, p1; qkt<4>(p0, p1, lds + G_K, r32, hi, qf);
#pragma unroll
    for (int r = 0; r < 16; ++r) { const int jj = crow(r, hi); p0[r] = (irow >= jj) ? p0[r] : 0.f; p1[r] = (irow >= jj + 32) ? p1[r] : 0.f; }
    bf16x8 pa0, pa1, pa2, pa3; pack_p(p0, p1, pa0, pa1, pa2, pa3);
    f32x16 o1[1] = {};
    pv_tile<0, 1>(o1, (int)(uintptr_t)(lds + G_V) + v_rd_base(lane) + dq * 512, pa0, pa1, pa2, pa3);
    pv_tile<0, 1>(o1, (int)(uintptr_t)(lds + G_S) + v_rd_base(lane) + dq * 512, qf[0], qf[1], qf[2], qf[3]);
    __syncthreads();
    float* obuf = (float*)lds;
#pragma unroll
    for (int r = 0; r < 16; ++r) obuf[(32 * rh + crow(r, hi)) * 128 + dq * 32 + r32] = o1[0][r];
    __syncthreads();
    { const int row = tid >> 3, c16 = (tid & 7) * 16; float ov[16]; float ss = 0.f;
#pragma unroll
      for (int q = 0; q < 4; ++q) { const f32x4 t = *(const f32x4*)(obuf + row * 128 + c16 + 4 * q); ov[4 * q] = t.x; ov[4 * q + 1] = t.y; ov[4 * q + 2] = t.z; ov[4 * q + 3] = t.w; ss += (t.x * t.x + t.y * t.y) + (t.z * t.z + t.w * t.w); }
      ss += __shfl_xor(ss, 1); ss += __shfl_xor(ss, 2); ss += __shfl_xor(ss, 4);
      const float rs = rsqrtf(ss * (1.f / 128.f) + RMS_EPS);
      const bf16* rb = QKV + (tok0 + row) * EVN + 1792 + h * 128 + c16; const float* on = P.in[I_BON] + jl * 128 + c16;
      bf16* op = (bf16*)(P.ws + WS_MIX) + (tok0 + row) * DM + 512 + h * 128 + c16;
#pragma unroll
      for (int hf = 0; hf < 2; ++hf) { const u32x4 gv = *(const u32x4*)(rb + 8 * hf); const f32x4 n0 = *(const f32x4*)(on + 8 * hf), n1 = *(const f32x4*)(on + 8 * hf + 4);
          const float* o8 = ov + 8 * hf;
          u32x4 w; w.x = cvtpk(o8[0] * rs * n0.x * silu_f(bflo(gv.x)), o8[1] * rs * n0.y * silu_f(bfhi(gv.x))); w.y = cvtpk(o8[2] * rs * n0.z * silu_f(bflo(gv.y)), o8[3] * rs * n0.w * silu_f(bfhi(gv.y)));
          w.z = cvtpk(o8[4] * rs * n1.x * silu_f(bflo(gv.z)), o8[5] * rs * n1.y * silu_f(bfhi(gv.z))); w.w = cvtpk(o8[6] * rs * n1.z * silu_f(bflo(gv.w)), o8[7] * rs * n1.w * silu_f(bfhi(gv.w)));
          *(u32x4*)(op + 8 * hf) = w; } }
    __syncthreads();
}
DEV void phase_gla_local(const Params& P, unsigned char* lds, int vb, int nvb, int layer) { for (int it = vb; it < 2048; it += nvb) gla_local_unit(P, (char*)lds, layer, it >> 8, (it >> 6) & 3, it & 63); }
DEV void phase_gla_final(const Params& P, unsigned char* lds, int vb, int nvb, int layer) { for (int it = vb; it < 2048; it += nvb) gla_final_unit(P, (char*)lds, layer, it >> 8, (it >> 6) & 3, it & 63); }
#undef KSWZ
#undef SBAR
}

template <int EPI  >
__global__ void __launch_bounds__(256) k_gemm_naive(const bf16* A, int lda, const float* W, int ldw, int K, int N, bf16* Ob, int ldc, const float* xin, float* xout, const float* gate) {
    const int col = (blockIdx.x * 64 + threadIdx.x) * 4, r0 = blockIdx.y * 16 + threadIdx.y * 4;
    if (col >= N) return;
    f32x4 acc[4];
#pragma unroll
    for (int i = 0; i < 4; ++i) acc[i] = (f32x4){0.f, 0.f, 0.f, 0.f};
    const bf16* a0 = A + (size_t)r0 * lda;
    for (int k = 0; k < K; ++k) {
        const f32x4 w = *(const f32x4*)(W + (size_t)k * ldw + col);
#pragma unroll
        for (int i = 0; i < 4; ++i) acc[i] += w * bf2f(a0[(size_t)i * lda + k]);
    }
#pragma unroll
    for (int i = 0; i < 4; ++i) {
        const int r = r0 + i;
        if (EPI == 0) { u32x2 o; o.x = pk2(acc[i].x, acc[i].y); o.y = pk2(acc[i].z, acc[i].w); *(u32x2*)(Ob + (size_t)r * ldc + col) = o; }
        else { const f32x4 g = *(const f32x4*)(gate + (size_t)(r >> 12) * (6 * DM) + col); const f32x4 xi = *(const f32x4*)(xin + (size_t)r * DM + col);
            *(f32x4*)(xout + (size_t)r * DM + col) = xi + g * acc[i]; }
    }
}
__global__ void __launch_bounds__(256) k_moe_up_naive(Params P, int layer) {
    const int col = (blockIdx.x * 64 + threadIdx.x) * 4, r0 = blockIdx.y * 16 + threadIdx.y * 4;
    const unsigned* cnt = (const unsigned*)(P.ws + WS_CTL) + CW_CNT + layer * 32;
    int e = -1, base = 0;
    { int a = 0; for (int i = 0; i < NEXP; ++i) { const int pc = ((int)cnt[i] + 255) & ~255; if (r0 >= a && r0 < a + pc) { e = i; base = a; } a += pc; } }
    if (e < 0) return;
    const int n = (int)cnt[e]; const int* LIST = (const int*)(P.ws + WS_LIST) + (size_t)e * NTOK;
    int tok[4]; bool ok[4];
#pragma unroll
    for (int i = 0; i < 4; ++i) { const int s = r0 + i - base; ok[i] = s < n; tok[i] = ok[i] ? (LIST[s] >> 1) : 0; }
    const bf16* H = (const bf16*)(P.ws + WS_H);
    const float* w1 = P.in[I_MW1] + ((size_t)layer * NEXP + e) * DM * MOEH + col; const float* w3 = P.in[I_MW3] + ((size_t)layer * NEXP + e) * DM * MOEH + col;
    f32x4 a1[4], a3[4];
#pragma unroll
    for (int i = 0; i < 4; ++i) { a1[i] = (f32x4){0.f, 0.f, 0.f, 0.f}; a3[i] = a1[i]; }
    for (int k = 0; k < DM; ++k) {
        const f32x4 u = *(const f32x4*)(w1 + (size_t)k * MOEH), w = *(const f32x4*)(w3 + (size_t)k * MOEH);
#pragma unroll
        for (int i = 0; i < 4; ++i) { const float hv = bf2f(H[(size_t)tok[i] * DM + k]); a1[i] += u * hv; a3[i] += w * hv; }
    }
    bf16* ACT = (bf16*)(P.ws + WS_ACT);
#pragma unroll
    for (int i = 0; i < 4; ++i) if (ok[i]) { u32x2 o; o.x = pk2(silu_f(a1[i].x) * a3[i].x, silu_f(a1[i].y) * a3[i].y); o.y = pk2(silu_f(a1[i].z) * a3[i].z, silu_f(a1[i].w) * a3[i].w);
        *(u32x2*)(ACT + (size_t)(r0 + i) * MOEH + col) = o; }
}
__global__ void __launch_bounds__(256) k_moe_down_naive(Params P, int layer) {
    const int col = (blockIdx.x * 64 + threadIdx.x) * 4, r0 = blockIdx.y * 16 + threadIdx.y * 4;
    const unsigned* cnt = (const unsigned*)(P.ws + WS_CTL) + CW_CNT + layer * 32;
    int e = -1, base = 0;
    { int a = 0; for (int i = 0; i < NEXP; ++i) { const int pc = ((int)cnt[i] + 255) & ~255; if (r0 >= a && r0 < a + pc) { e = i; base = a; } a += pc; } }
    if (e < 0) return;
    const int n = (int)cnt[e];
    if (r0 - base >= n) return;
    const bf16* ACT = (const bf16*)(P.ws + WS_ACT) + (size_t)r0 * MOEH;
    const float* w2 = P.in[I_MW2] + ((size_t)layer * NEXP + e) * MOEH * DM + col;
    f32x4 acc[4];
#pragma unroll
    for (int i = 0; i < 4; ++i) acc[i] = (f32x4){0.f, 0.f, 0.f, 0.f};
    for (int k = 0; k < MOEH; ++k) {
        const f32x4 w = *(const f32x4*)(w2 + (size_t)k * DM);
#pragma unroll
        for (int i = 0; i < 4; ++i) acc[i] += w * ((r0 + i - base < n) ? bf2f(ACT[(size_t)i * MOEH + k]) : 0.f);
    }
    bf16* YP = (bf16*)(P.ws + WS_YP);
#pragma unroll
    for (int i = 0; i < 4; ++i) if (r0 + i - base < n) { u32x2 o; o.x = pk2(acc[i].x, acc[i].y); o.y = pk2(acc[i].z, acc[i].w); *(u32x2*)(YP + (size_t)(r0 + i) * DM + col) = o; }
}
__global__ void __launch_bounds__(512) k_swa_naive(Params P, int layer) {
    __shared__ float qs[8][64];
    const int r = blockIdx.x, lane = threadIdx.x & 63, h = threadIdx.x >> 6, kvh = h >> 2, b = r >> 12, t = r & (SEQ - 1), jl = layer >> 1;
    const bf16* QKV = (const bf16*)(P.ws + WS_BIG); const float* BT = (const float*)(P.ws + WS_BT);
    { const float q = bf2f(QKV[(size_t)r * EVN + h * 64 + lane]); const float rs = rsqrtf(wave_sum(q * q) * (1.f / 64.f) + RMS_EPS);
      qs[h][lane] = q * rs * P.in[I_AQN][jl * 64 + lane] * P.in[I_AKN][jl * 64 + lane]; }
    __syncthreads();
    float lg[2];
#pragma unroll
    for (int i = 0; i < 2; ++i) { const int dist = i * 64 + lane, s = t - dist; lg[i] = -INFINITY;
        if (s >= 0) { const bf16* kr = QKV + ((size_t)b * SEQ + s) * EVN + 512 + kvh * 64; float dot = 0.f, kss = 0.f;
#pragma unroll 8
            for (int d = 0; d < 64; ++d) { const float kv = bf2f(kr[d]); dot += qs[h][d] * kv; kss += kv * kv; }
            lg[i] = dot * rsqrtf(kss * (1.f / 64.f) + RMS_EPS) * 0.125f + BT[h * 128 + dist]; } }
    const float sink = P.in[I_ASINK][jl * 8 + h];
    const float m = fmaxf(wave_max(fmaxf(lg[0], lg[1])), sink);
    float p[2];
#pragma unroll
    for (int i = 0; i < 2; ++i) p[i] = (lg[i] == -INFINITY) ? 0.f : __expf(lg[i] - m);
    const float den = wave_sum(p[0] + p[1]) + __expf(sink - m);
    float o = 0.f;
#pragma unroll
    for (int i = 0; i < 2; ++i)
        for (int src = 0; src < 64; ++src) { const float ps = __shfl(p[i], src); const int s = t - (i * 64 + src);
            if (s >= 0) o += ps * bf2f(QKV[((size_t)b * SEQ + s) * EVN + 640 + kvh * 64 + lane]); }
    ((bf16*)(P.ws + WS_MIX))[(size_t)r * DM + h * 64 + lane] = (bf16)f2bf(o / den);
}
__global__ void __launch_bounds__(256) k_gla_decay_naive(Params P, int layer) {
    const int r = blockIdx.x, c = threadIdx.x, jl = layer >> 1;
    const float* ab = (const float*)(P.ws + WS_AB) + (size_t)r * 16; const float* gu = P.in[I_BGU] + (size_t)jl * 16 * 256;
    float z = P.in[I_BGB][jl * 256 + c];
#pragma unroll
    for (int j = 0; j < 16; ++j) z += ab[j] * gu[j * 256 + c];
    ((float*)(P.ws + WS_UPD))[(size_t)r * 256 + c] = __expf(log_sigmoid_f(z) * (1.f / 16.f));
}
__global__ void __launch_bounds__(128) k_gla_scan_naive(Params P, int layer) {
    const int b = blockIdx.x >> 2, h = blockIdx.x & 3, dv = threadIdx.x;
    const bf16* QKV = (const bf16*)(P.ws + WS_BIG); const float* A = (const float*)(P.ws + WS_UPD); float* O = (float*)(P.ws + WS_SIN);
    float S[64];
#pragma unroll
    for (int d = 0; d < 64; ++d) S[d] = 0.f;
    for (int t = 0; t < SEQ; ++t) {
        const size_t r = (size_t)b * SEQ + t;
        const bf16* row = QKV + r * EVN; const float* ar = A + r * 256 + h * 64;
        const float v = bf2f(row[1280 + h * 128 + dv]);
        float o = 0.f;
#pragma unroll
        for (int d = 0; d < 64; ++d) { S[d] = ar[d] * S[d] + bf2f(row[1024 + h * 64 + d]) * v; o += bf2f(row[768 + h * 64 + d]) * S[d]; }
        O[r * 512 + h * 128 + dv] = o * 0.125f;
    }
}
__global__ void __launch_bounds__(256) k_gla_fin_naive(Params P, int layer) {
    const int r = blockIdx.x, lane = threadIdx.x & 63, h = threadIdx.x >> 6, jl = layer >> 1;
    const float* O = (const float*)(P.ws + WS_SIN) + (size_t)r * 512 + h * 128 + 2 * lane; const bf16* QKV = (const bf16*)(P.ws + WS_BIG);
    const float o0 = O[0], o1 = O[1]; const float rs = rsqrtf(wave_sum(o0 * o0 + o1 * o1) * (1.f / 128.f) + RMS_EPS);
    const unsigned g = *(const unsigned*)(QKV + (size_t)r * EVN + 1792 + h * 128 + 2 * lane);
    const float* on = P.in[I_BON] + jl * 128 + 2 * lane;
    *(unsigned*)((bf16*)(P.ws + WS_MIX) + (size_t)r * DM + 512 + h * 128 + 2 * lane) = pk2(o0 * rs * on[0] * silu_f(bflo(g)), o1 * rs * on[1] * silu_f(bfhi(g)));
}
__global__ void __launch_bounds__(512) k_moba_naive(Params P, int layer) {
    __shared__ float qs[8][128];
    const int r = blockIdx.x, lane = threadIdx.x & 63, h = threadIdx.x >> 6, b = r >> 12, t = r & (SEQ - 1), qblk = t >> 8, jl = layer >> 1;
    const bf16* QKV = (const bf16*)(P.ws + WS_BIG); const float* BT = (const float*)(P.ws + WS_BT) + h * 128; const float* KM = (const float*)(P.ws + WS_KMEAN);
    { const unsigned u = *(const unsigned*)(QKV + (size_t)r * ODN + h * 128 + 2 * lane); const float q0 = bflo(u), q1 = bfhi(u);
      const float rs = rsqrtf(wave_sum(q0 * q0 + q1 * q1) * (1.f / 128.f) + RMS_EPS); const float* qn = P.in[I_CQN] + jl * 128 + 2 * lane;
      qs[h][2 * lane] = q0 * rs * qn[0]; qs[h][2 * lane + 1] = q1 * rs * qn[1]; }
    __syncthreads();
    float sc = -INFINITY;
    if (lane < qblk) { const float* km = KM + (((size_t)b * 16 + lane) * 8 + h) * 128; float d = 0.f; for (int i = 0; i < 128; ++i) d += qs[h][i] * km[i]; sc = d; }
    int blk[4]; blk[0] = qblk;
#pragma unroll
    for (int n = 0; n < 3; ++n) { const float mx = wave_max(sc); const unsigned long long bal = __ballot(sc == mx && mx > -INFINITY);
        const int idx = bal ? (__ffsll((long long)bal) - 1) : -1; blk[1 + n] = idx; if (lane == idx) sc = -INFINITY; }
    float lg[4][4];
#pragma unroll
    for (int s = 0; s < 4; ++s)
#pragma unroll
        for (int rr = 0; rr < 4; ++rr) { lg[s][rr] = -INFINITY;
            if (blk[s] >= 0) { const int key = blk[s] * 256 + rr * 64 + lane, dist = t - key;
                if (dist >= 0) { const bf16* kr = QKV + ((size_t)b * SEQ + key) * ODN + 1024 + h * 128; float dot = 0.f;
#pragma unroll 8
                    for (int d = 0; d < 128; ++d) dot += qs[h][d] * bf2f(kr[d]);
                    lg[s][rr] = dot * 0.08838834764831845f + BT[dist < 127 ? dist : 127]; } } }
    float m = -INFINITY;
#pragma unroll
    for (int s = 0; s < 4; ++s)
#pragma unroll
        for (int rr = 0; rr < 4; ++rr) m = fmaxf(m, lg[s][rr]);
    m = wave_max(m);
    float den = 0.f;
#pragma unroll
    for (int s = 0; s < 4; ++s)
#pragma unroll
        for (int rr = 0; rr < 4; ++rr) { lg[s][rr] = (lg[s][rr] == -INFINITY) ? 0.f : __expf(lg[s][rr] - m); den += lg[s][rr]; }
    den = wave_sum(den);
    float o0 = 0.f, o1 = 0.f;
#pragma unroll
    for (int s = 0; s < 4; ++s)
#pragma unroll
        for (int rr = 0; rr < 4; ++rr) {
            if (blk[s] < 0) continue;
            for (int src = 0; src < 64; ++src) { const float ps = __shfl(lg[s][rr], src); const int key = blk[s] * 256 + rr * 64 + src;
                if (key <= t) { const unsigned u = *(const unsigned*)(QKV + ((size_t)b * SEQ + key) * ODN + 2048 + h * 128 + 2 * lane); o0 += ps * bflo(u); o1 += ps * bfhi(u); } } }
    *(unsigned*)((bf16*)(P.ws + WS_MIX) + (size_t)r * DM + h * 128 + 2 * lane) = pk2(o0 / den, o1 / den);
}

#define XB_TMO      128
#define XB_XCNT(j)  (256  + 64 * (j))
#define XB_XSUB(j)  (1280 + 64 * (j))
#define XB_XGEN(j)  (2304 + 64 * (j))
#define XB_TOP      3328
#define XB_TOPGEN   3392
#define XCD_BAR_WORDS 3456
#define XB_SPIN_CAP (1u << 18)
#define LAS __attribute__((address_space(3)))

__device__ __forceinline__ unsigned xb_ld(unsigned* p)              { return __hip_atomic_load(p, __ATOMIC_RELAXED, __HIP_MEMORY_SCOPE_AGENT); }
__device__ __forceinline__ unsigned xb_add(unsigned* p, unsigned v) { return __hip_atomic_fetch_add(p, v, __ATOMIC_RELAXED, __HIP_MEMORY_SCOPE_AGENT); }
__device__ __forceinline__ unsigned xb_xcc_id() { return (unsigned)__builtin_amdgcn_s_getreg((3 << 11) | 20) & 0xFu; }
#define XB_SPIN(cond, bar) do { unsigned _sp = 0; while (cond) { __builtin_amdgcn_s_sleep(1); \
    if ((++_sp & 255u) == 0u) { if (xb_ld(&(bar)[XB_TMO])) break; if (_sp > XB_SPIN_CAP) { atomicAdd(&(bar)[XB_TMO], 1u); break; } } } } while (0)

struct XcdBarrier {
    unsigned* bar; unsigned x;
    volatile LAS unsigned* st;
};
__device__ __forceinline__ XcdBarrier xcd_barrier_post(unsigned* bar, volatile LAS unsigned* st) {
    XcdBarrier b; b.bar = bar; b.x = xb_xcc_id(); b.st = st;
    if (threadIdx.x == 0) (void)xb_add(&bar[XB_XCNT(b.x)], 1u);
    return b;
}
__device__ __forceinline__ void xcd_barrier_complete(unsigned* bar, unsigned x, unsigned& nloc, unsigned& nx) {
    const unsigned G = gridDim.x * gridDim.y * gridDim.z;
    unsigned sum, cnt, mine, sp = 0u;
    for (;;) {
        sum = 0u; cnt = 0u; mine = 0u;
#pragma unroll
        for (unsigned j = 0; j < 16; ++j) { const unsigned c = xb_ld(&bar[XB_XCNT(j)]); sum += c; cnt += (c > 0u) ? 1u : 0u; mine = (j == x) ? c : mine; }
        if (sum == G) break;
        __builtin_amdgcn_s_sleep(1);
        if ((++sp & 255u) == 0u) { if (xb_ld(&bar[XB_TMO])) break; if (sp > XB_SPIN_CAP) { atomicAdd(&bar[XB_TMO], 1u); break; } }
    }
    nloc = mine > 0u ? mine : 1u; nx = cnt > 0u ? cnt : 1u;
}
__device__ __forceinline__ void xcd_barrier(const XcdBarrier& b) {
    asm volatile("s_waitcnt vmcnt(0)" ::: "memory");
    __syncthreads();
    if (threadIdx.x == 0) {
        unsigned* bar = b.bar;
        __builtin_amdgcn_s_waitcnt(0);
        unsigned nloc = b.st[0], nx = b.st[1];
        if (nloc == 0u) { xcd_barrier_complete(bar, b.x, nloc, nx); b.st[0] = nloc; b.st[1] = nx; }
        const unsigned old = xb_add(&bar[XB_XSUB(b.x)], 1u);
        const unsigned gen = old / nloc;
        if (old + 1u == (gen + 1u) * nloc) {
            __builtin_amdgcn_fence(__ATOMIC_RELEASE, "agent");
            asm volatile("s_waitcnt vmcnt(0)" ::: "memory");
            const unsigned og = xb_add(&bar[XB_TOP], 1u);
            const unsigned tg = og / nx;
            if (og + 1u == (tg + 1u) * nx) xb_add(&bar[XB_TOPGEN], 1u);
            else XB_SPIN(xb_ld(&bar[XB_TOPGEN]) == tg, bar);
            __builtin_amdgcn_fence(__ATOMIC_ACQUIRE, "agent");
            xb_add(&bar[XB_XGEN(b.x)], 1u);
            asm volatile("s_waitcnt vmcnt(0)" ::: "memory");
        } else {
            XB_SPIN(xb_ld(&bar[XB_XGEN(b.x)]) == gen, bar);
            __builtin_amdgcn_fence(__ATOMIC_ACQUIRE, "agent");
            asm volatile("s_waitcnt vmcnt(0)" ::: "memory");
        }
    }
    __syncthreads();
}

constexpr int LDS_AUX_OFF = 147456, LDS_MISC_OFF = 151552, LDS_BYTES = 155648;
constexpr int N_PHASES = 34;
#ifndef REP
#define REP -1
#endif
#define RUN(k, ...) do { { const int dry = 0; (void)dry; __VA_ARGS__; } if (REP == (k)) { const int dry = P.pad; (void)dry; __VA_ARGS__; } } while (0)
__global__ void __launch_bounds__(512, 2) mega(Params P) {
    extern __shared__ __attribute__((aligned(16))) unsigned char lds[];
    const int tid = threadIdx.x;
    const int G = gridDim.x, bx = blockIdx.x, vcu = (G % 8 == 0) ? (bx % 8) * (G / 8) + bx / 8 : bx;
    volatile LAS unsigned* MISC = (volatile LAS unsigned*)(lds + LDS_MISC_OFF);
    if (tid < 8) MISC[tid] = 0u;
    __syncthreads();
    unsigned* ctl = (unsigned*)(P.ws + WS_CTL);
    const XcdBarrier bar = xcd_barrier_post(ctl + CW_BAR + P.li * XCD_BAR_WORDS, MISC);
    const int lo = P.ph_lo, hi = P.ph_hi; int ph = 0;
    float* X = P.out; float* MOD = (float*)(P.ws + WS_MOD);
    bf16* H = (bf16*)(P.ws + WS_H); bf16* QKV = (bf16*)(P.ws + WS_BIG); bf16* MIX = (bf16*)(P.ws + WS_MIX); bf16* ACT = (bf16*)(P.ws + WS_ACT); bf16* YP = (bf16*)(P.ws + WS_YP);
    PG8_LAS unsigned char* ldsg = (PG8_LAS unsigned char*)lds;
#define PH_BEGIN if (ph >= lo && ph < hi) { const int l = opaque_s(l_), odd = l & 1, lp = l >> 1; (void)odd; (void)lp;
#define PH_END if (ph + 1 < hi) xcd_barrier(bar); } ++ph;
    { const int l_ = 0; PH_BEGIN RUN(0, phase_prologue(P, lds, vcu, G, true)); PH_END }
#pragma unroll 1
    for (int l_ = 0; l_ <= DEPTH; ++l_) {
        const int odd_ = l_ & 1;
        bool done = false;
#pragma unroll 1
        for (int half = 0; half < 2 && !done; ++half) {
            PH_BEGIN
                { const int mode = (l == DEPTH) ? 0 : (half ? 3 : (odd ? 2 : 1));
                  if (mode == 3) RUN(10, phase_norm(P, lds, vcu, G, mode, l, (const float*)X, (float*)nullptr, -1, dry)); else RUN(9, phase_norm(P, lds, vcu, G, mode, l, (l == 0 && !half) ? P.in[I_X] : (const float*)X, X, l - 1, dry)); }
            PH_END
            if (l_ == DEPTH) { done = true; continue; }
            if (!half) {
                PH_BEGIN
                    { const int N = odd ? ODN : EVN; const bf16* wt = odd ? (const bf16*)(P.ws + WS_WOI) + (size_t)lp * ODN * DM : (const bf16*)(P.ws + WS_WEI) + (size_t)lp * EVN * DM;
                      pg8::Gemm g{H, wt, DM, 0}; pg8::StaticOrder S; S.init(NTOK, N, G, bx); pg8::EpiQKV E{QKV, N, odd, P.in[I_CKN] + lp * 128, (float*)(P.ws + WS_KMEAN), (PG8_LAS float*)(ldsg + 131072)}; RUN(1, pg8::gemm_phase(ldsg, g, S, E)); }
                PH_END
                if (!odd_) {
                    PH_BEGIN RUN(2, att::phase_swa(P, lds, vcu, G, l)); RUN(3, att::phase_gla_local(P, lds, vcu, G, l)); PH_END
                    PH_BEGIN RUN(4, att::phase_gla_scan(P, vcu, G)); PH_END
                    PH_BEGIN RUN(5, att::phase_gla_final(P, lds, vcu, G, l)); PH_END
                } else {
                    PH_BEGIN RUN(6, att::phase_moba(P, lds, vcu, G, l)); PH_END
                }
                PH_BEGIN
                    { pg8::Gemm g{MIX, (const bf16*)(P.ws + (odd ? WS_WOO : WS_WEO)) + (size_t)lp * DM * DM, DM, 0}; pg8::StaticOrder S; S.init(NTOK, DM, G, bx);
                      RUN(11, { pg8::EpiResid E{(l == 0) ? P.in[I_X] : (const float*)X, X, MOD + (size_t)l * NBATCH * 6 * DM + 2 * DM, dry}; pg8::gemm_phase(ldsg, g, S, E); }); }
                PH_END
            } else {
#pragma unroll 1
                for (int dn = 0; dn < 2; ++dn) {
                    PH_BEGIN
                        { const int tid = opaque_tid(); PG8_LAS int* tp = (PG8_LAS int*)(ldsg + LDS_AUX_OFF); PG8_LAS unsigned* cl = (PG8_LAS unsigned*)(tp + 64); const unsigned* cnt = ctl + CW_CNT + l * 32;
                          if (tid == 0) { int a = 0; for (int e = 0; e < NEXP; ++e) { tp[e] = a; a += ((int)cnt[e] + 255) >> 8; } tp[NEXP] = a; }
                          if (tid < 32) cl[tid] = cnt[tid];
                          __syncthreads();
                          if (!dn) { pg8::Gemm g{H, (const bf16*)(P.ws + WS_WUP) + (size_t)l * NEXP * 1024 * DM, DM, (size_t)1024 * DM};
                              pg8::MoeOrder<true> S{tp, cl, (const int*)(P.ws + WS_LIST), tp + 256, 4, G, vcu}; pg8::EpiSiluMul E{ACT}; RUN(7, pg8::gemm_phase(ldsg, g, S, E)); }
                          else { pg8::Gemm g{ACT, (const bf16*)(P.ws + WS_WDN) + (size_t)l * NEXP * DM * MOEH, MOEH, (size_t)DM * MOEH};
                              pg8::MoeOrder<false> S{tp, cl, (const int*)(P.ws + WS_LIST), tp + 256, 4, G, vcu}; pg8::EpiBf16 E{YP, DM}; RUN(8, pg8::gemm_phase(ldsg, g, S, E)); } }
                    PH_END
                }
            }
        }
    }
#undef PH_BEGIN
#undef PH_END
}

extern "C" void kernel_launch(void* const* d_in, const int* in_sizes, int n_in, void* d_out, int out_size, void* d_ws, size_t ws_size, hipStream_t stream) {
    static int ok = 0, grid = 0;
    constexpr int LDS_NORM = LDS_BYTES;
    if (ok == 0) {
        if (n_in != N_IN || out_size != NTOK * DM || ws_size < WS_END) { fprintf(stderr, "kernel_launch: unexpected shapes (n_in %d out %d ws %zu need %zu)\n", n_in, out_size, ws_size, (size_t)WS_END); ok = -1; return; }
        int dev = 0, cus = 0;
        if (hipGetDevice(&dev) != hipSuccess || hipDeviceGetAttribute(&cus, hipDeviceAttributeMultiprocessorCount, dev) != hipSuccess) { ok = -1; return; }
        if (hipFuncSetAttribute((const void*)k_norm, hipFuncAttributeMaxDynamicSharedMemorySize, LDS_NORM) != hipSuccess) { fprintf(stderr, "kernel_launch: hipFuncSetAttribute failed\n"); ok = -1; return; }
        if (hipFuncSetAttribute((const void*)mega, hipFuncAttributeMaxDynamicSharedMemorySize, LDS_BYTES) != hipSuccess) { fprintf(stderr, "kernel_launch: hipFuncSetAttribute(mega) failed\n"); ok = -1; return; }
        int per_cu = 0;
        if (hipOccupancyMaxActiveBlocksPerMultiprocessor(&per_cu, (const void*)mega, 512, LDS_BYTES) != hipSuccess || per_cu < 1) fprintf(stderr, "kernel_launch: occupancy query says %d blocks per CU\n", per_cu);
        (void)hipGetLastError();
        grid = cus;
        ok = 1;
    }
    if (ok < 0) return;
    Params P{};
    for (int i = 0; i < N_IN; ++i) P.in[i] = (const float*)d_in[i];
    P.out = (float*)d_out; P.ws = (unsigned char*)d_ws; P.ph_lo = 0; P.ph_hi = 0; P.li = 0; P.pad = (REP >= 0) ? 1 : 0;
    (void)hipMemsetAsync((char*)d_ws + WS_CTL, 0, CTL_BYTES, stream);
    int li = 0;
    auto run = [&](int lo, int hi) { P.ph_lo = lo; P.ph_hi = hi; P.li = li++; hipLaunchKernelGGL(mega, dim3(grid), dim3(512), LDS_BYTES, stream, P); };
    run(0, N_PHASES);
}
```
